# Optimizing an MI355X kernel written in HIP

```python
import jax
import jax.numpy as jnp
from jax import lax
import numpy as np

D_MODEL = 2048
BATCH = 4
SEQ = 2048
DEPTH = 4
DEC_BATCH = 8
DEC_SEQ = 4
PAST_LEN = 16384
PAGE_SIZE = 128

N_MIXERS = 3
N_POOL_LAYERS = (DEPTH + 2) // 3
N_CHUNK_LAYERS = (DEPTH + 1) // 3
N_ATTN_LAYERS = DEPTH // 3

D_FF = 5504
RMS_EPS = 1e-6

POOL_WINDOWS = (2, 4, 8, 16)
POOL_GROUP = D_MODEL // len(POOL_WINDOWS)
POOL_BUF = max(POOL_WINDOWS) - 1

CHUNK = 128
CHUNK_WIDTH = D_MODEL
CHUNK_GROUPS = 8
CHUNK_GROUP_W = CHUNK_WIDTH // CHUNK_GROUPS

ATTN_GROUPS = ((128, 1), (512, 4), (2048, 16))
N_ATTN_GROUPS = len(ATTN_GROUPS)
HEADS_PER_GROUP = 16
HEAD_DIM = 128
ROPE_THETA = 10000.0
ATTN_SCALE = HEAD_DIM ** -0.5
NEG = float(np.finfo(np.float32).min)

kernel_name = 'hybrid_pool_chunkgmlp_dilated_attn_decode_step'


def rms_norm(x, g):
    x32 = x.astype(jnp.float32)
    y = x32 * lax.rsqrt(jnp.mean(x32 * x32, axis=-1, keepdims=True) + RMS_EPS)
    return (y * g.astype(jnp.float32)).astype(x.dtype)


def swiglu(h, w_in, w_out):
    gate, up = jnp.split(h @ w_in, 2, axis=-1)
    return (jax.nn.silu(gate) * up) @ w_out


def pool_mixer(h, buf, start, w_pool, scale):
    B, T, _ = h.shape
    hb = jnp.concatenate([buf.astype(h.dtype), h], axis=1)
    hb32 = hb.astype(jnp.float32)
    cs = jnp.concatenate([jnp.zeros_like(hb32[:, :1]), jnp.cumsum(hb32, axis=1)], axis=1)
    pos = start + jnp.arange(T)
    h32 = h.astype(jnp.float32)
    hi = POOL_BUF + 1
    groups = []
    for g, w in enumerate(POOL_WINDOWS):
        sl = slice(g * POOL_GROUP, (g + 1) * POOL_GROUP)
        win_sum = cs[:, hi:hi + T, sl] - cs[:, hi - w:hi - w + T, sl]
        count = jnp.minimum(w, pos + 1).astype(jnp.float32)
        groups.append(win_sum / count[None, :, None] - h32[:, :, sl])
    pooled = jnp.stack(groups, axis=2)
    mixed = jnp.einsum('btgc,gcd->btgd', pooled, w_pool.astype(jnp.float32))
    out = mixed.reshape(B, T, D_MODEL) * scale.astype(jnp.float32)
    return out.astype(h.dtype), hb[:, -POOL_BUF:]


def chunk_proj(h, w_in, v_gain):
    u, v = jnp.split(jax.nn.gelu(h @ w_in, approximate=False), 2, axis=-1)
    return u, rms_norm(v, v_gain)


def causal_ws(w_s):
    mask = jnp.tril(jnp.ones((CHUNK, CHUNK), dtype=bool))
    return jnp.where(mask[None], w_s, jnp.zeros_like(w_s))


def chunk_mixer_prompt(h, w_in, v_gain, w_s, b_s, w_out):
    B, S, _ = h.shape
    u, v = chunk_proj(h, w_in, v_gain)
    vc = v.reshape(B, S // CHUNK, CHUNK, CHUNK_GROUPS, CHUNK_GROUP_W)
    mixed = jnp.einsum('bncgd,gqc->bnqgd', vc, causal_ws(w_s).astype(v.dtype))
    mixed = mixed + b_s.T.astype(v.dtype)[None, None, :, :, None]
    return (u * mixed.reshape(B, S, CHUNK_WIDTH)) @ w_out


def chunk_mixer_sample(h, w_in, v_gain, w_s, b_s, w_out):
    B, T, _ = h.shape
    u, v = chunk_proj(h, w_in, v_gain)
    ws = causal_ws(w_s)[:, :T, :T].astype(v.dtype)
    mixed = jnp.einsum('btgd,gqt->bqgd', v.reshape(B, T, CHUNK_GROUPS, CHUNK_GROUP_W), ws)
    mixed = mixed + b_s[:, :T].T.astype(v.dtype)[None, :, :, None]
    return (u * mixed.reshape(B, T, CHUNK_WIDTH)) @ w_out, v


def rope(x, pos):
    half = HEAD_DIM // 2
    freqs = ROPE_THETA ** (-2.0 * jnp.arange(half, dtype=jnp.float32) / HEAD_DIM)
    ang = pos.astype(jnp.float32)[:, None] * freqs[None, :]
    cos = jnp.cos(ang)[None, :, None, None, :]
    sin = jnp.sin(ang)[None, :, None, None, :]
    x32 = x.astype(jnp.float32)
    x1, x2 = x32[..., :half], x32[..., half:]
    return jnp.concatenate([x1 * cos - x2 * sin, x1 * sin + x2 * cos], axis=-1).astype(x.dtype)


def attn_qkv(h, pos, w_qkv, q_gain, k_gain):
    B, T, _ = h.shape
    qkv = (h @ w_qkv).reshape(B, T, 3, N_ATTN_GROUPS, HEADS_PER_GROUP, HEAD_DIM)
    q = rope(rms_norm(qkv[:, :, 0], q_gain), pos)
    k = rope(rms_norm(qkv[:, :, 1], k_gain), pos)
    return q, k, qkv[:, :, 2]


def dilated_attn_prompt(q, k, v, window, dil):
    B, S, H, E = q.shape
    R = window // dil
    n = S // dil
    nb = -(-n // R)
    n_pad = nb * R

    def to_blocks(x):
        x = x.reshape(B, n, dil, H, E).transpose(0, 2, 1, 3, 4)
        x = jnp.pad(x, ((0, 0), (0, 0), (0, n_pad - n), (0, 0), (0, 0)))
        return x.reshape(B, dil, nb, R, H, E)

    def with_prev(x):
        prev = jnp.pad(x, ((0, 0), (0, 0), (1, 0), (0, 0), (0, 0), (0, 0)))[:, :, :nb]
        return jnp.concatenate([prev, x], axis=3)

    qb = to_blocks(q)
    kk = with_prev(to_blocks(k))
    vv = with_prev(to_blocks(v))
    s = jnp.einsum('brnqhe,brnkhe->brnhqk', qb, kk, preferred_element_type=jnp.float32) * ATTN_SCALE
    qi = jnp.arange(R)[:, None]
    kj = jnp.arange(2 * R)[None, :]
    dist = R + qi - kj
    band = (dist >= 0) & (dist <= R)
    key_m = (jnp.arange(nb) * R - R)[:, None, None] + kj[None]
    mask = band[None] & (key_m >= 0)
    s = jnp.where(mask[None, None, :, None], s, NEG)
    lse = jax.nn.logsumexp(s, axis=-1)
    p = jnp.exp(s - lse[..., None])
    o = jnp.einsum('brnhqk,brnkhe->brnqhe', p, vv.astype(jnp.float32))
    o = o.reshape(B, dil, n_pad, H, E)[:, :, :n].transpose(0, 2, 1, 3, 4).reshape(B, S, H, E)
    lse = lse.transpose(0, 1, 2, 4, 3).reshape(B, dil, n_pad, H)[:, :, :n]
    lse = lse.transpose(0, 2, 1, 3).reshape(B, S, H)
    return o, lse


def dilated_attn_sample(q, k_new, v_new, cache_kv, window, dil):
    B, T, H, E = q.shape
    L = cache_kv.shape[1]
    R = window // dil
    k_all = jnp.concatenate([cache_kv[:, :, 0].astype(k_new.dtype), k_new], axis=1)
    v_all = jnp.concatenate([cache_kv[:, :, 1].astype(v_new.dtype), v_new], axis=1)
    idx = L + jnp.arange(T)[:, None] - dil * jnp.arange(R + 1)[None, :]
    valid = idx >= 0
    idx_c = jnp.clip(idx, 0, L + T - 1)
    kg = k_all[:, idx_c]
    vg = v_all[:, idx_c]
    s = jnp.einsum('bthe,btkhe->bthk', q, kg, preferred_element_type=jnp.float32) * ATTN_SCALE
    s = jnp.where(valid[None, :, None, :], s, NEG)
    lse = jax.nn.logsumexp(s, axis=-1)
    p = jnp.exp(s - lse[..., None])
    o = jnp.einsum('bthk,btkhe->bthe', p, vg.astype(jnp.float32))
    return o, lse


def combine_groups(outs, lses, w_out, dtype):
    alpha = jax.nn.softmax(jnp.stack(lses, axis=0), axis=0)
    o = jnp.einsum('gbth,gbthe->bthe', alpha, jnp.stack(outs, axis=0).astype(jnp.float32))
    B, T = o.shape[:2]
    return o.reshape(B, T, HEADS_PER_GROUP * HEAD_DIM).astype(dtype) @ w_out


def attn_mixer_prompt(h, w_qkv, q_gain, k_gain, w_out):
    B, S, _ = h.shape
    q, k, v = attn_qkv(h, jnp.arange(S), w_qkv, q_gain, k_gain)
    outs, lses, rows = [], [], []
    for g, (window, dil) in enumerate(ATTN_GROUPS):
        o, l = dilated_attn_prompt(q[:, :, g], k[:, :, g], v[:, :, g], window, dil)
        outs.append(o)
        lses.append(l)
        keep = min(window, S)
        rows.append(jnp.stack([k[:, S - keep:, g], v[:, S - keep:, g]], axis=2))
    return combine_groups(outs, lses, w_out, h.dtype), rows


def attn_mixer_sample(h, caches, w_qkv, q_gain, k_gain, w_out):
    B, T, _ = h.shape
    q, k, v = attn_qkv(h, PAST_LEN + jnp.arange(T), w_qkv, q_gain, k_gain)
    outs, lses, rows = [], [], []
    for g, (window, dil) in enumerate(ATTN_GROUPS):
        o, l = dilated_attn_sample(q[:, :, g], k[:, :, g], v[:, :, g], caches[g], window, dil)
        outs.append(o)
        lses.append(l)
        rows.append(jnp.stack([k[:, :, g], v[:, :, g]], axis=2))
    return combine_groups(outs, lses, w_out, h.dtype), rows


def setup_inputs(seed: int = 0) -> dict:
    key = jax.random.key(seed)
    ks = jax.random.split(key, 32)
    f32 = jnp.float32

    def nrm(k, shape, scale):
        return jax.random.normal(k, shape, f32) * scale

    def gain(k, shape, noise):
        return 1.0 + noise * jax.random.normal(k, shape, f32)

    attn_w = N_ATTN_GROUPS * HEADS_PER_GROUP * HEAD_DIM
    inp = {}
    inp['x_prompt'] = nrm(ks[0], (BATCH, SEQ, D_MODEL), 1.0)
    inp['x_sample'] = nrm(ks[1], (DEC_BATCH, DEC_SEQ, D_MODEL), 1.0)
    inp['state_pool'] = nrm(ks[2], (N_POOL_LAYERS, DEC_BATCH, POOL_BUF, D_MODEL), 1.0)
    for g, (window, _) in enumerate(ATTN_GROUPS):
        keep = min(window, PAST_LEN)
        inp['cache_kv_g%d' % g] = nrm(ks[3 + g], (N_ATTN_LAYERS, DEC_BATCH, keep, 2, HEADS_PER_GROUP, HEAD_DIM), 1.0)
    inp['norm_ffn1'] = gain(ks[6], (DEPTH, D_MODEL), 0.05)
    inp['ffn1_w_in'] = nrm(ks[7], (DEPTH, D_MODEL, 2 * D_FF), D_MODEL ** -0.5)
    inp['ffn1_w_out'] = nrm(ks[8], (DEPTH, D_FF, D_MODEL), D_FF ** -0.5)
    inp['norm_mix'] = gain(ks[9], (DEPTH, D_MODEL), 0.05)
    inp['norm_ffn2'] = gain(ks[10], (DEPTH, D_MODEL), 0.05)
    inp['ffn2_w_in'] = nrm(ks[11], (DEPTH, D_MODEL, 2 * D_FF), D_MODEL ** -0.5)
    inp['ffn2_w_out'] = nrm(ks[12], (DEPTH, D_FF, D_MODEL), D_FF ** -0.5)
    inp['pool_w'] = nrm(ks[13], (N_POOL_LAYERS, len(POOL_WINDOWS), POOL_GROUP, POOL_GROUP), POOL_GROUP ** -0.5)
    inp['pool_scale'] = gain(ks[14], (N_POOL_LAYERS, D_MODEL), 0.1)
    inp['chunk_w_in'] = nrm(ks[15], (N_CHUNK_LAYERS, D_MODEL, 2 * CHUNK_WIDTH), D_MODEL ** -0.5)
    inp['chunk_v_norm'] = gain(ks[16], (N_CHUNK_LAYERS, CHUNK_WIDTH), 0.05)
    inp['chunk_w_s'] = nrm(ks[17], (N_CHUNK_LAYERS, CHUNK_GROUPS, CHUNK, CHUNK), CHUNK ** -0.5)
    inp['chunk_b_s'] = gain(ks[18], (N_CHUNK_LAYERS, CHUNK_GROUPS, CHUNK), 0.1)
    inp['chunk_w_out'] = nrm(ks[19], (N_CHUNK_LAYERS, CHUNK_WIDTH, D_MODEL), CHUNK_WIDTH ** -0.5)
    inp['attn_w_qkv'] = nrm(ks[20], (N_ATTN_LAYERS, D_MODEL, 3 * attn_w), D_MODEL ** -0.5)
    inp['attn_q_norm'] = gain(ks[21], (N_ATTN_LAYERS, HEAD_DIM), 0.05)
    inp['attn_k_norm'] = gain(ks[22], (N_ATTN_LAYERS, HEAD_DIM), 0.05)
    inp['attn_w_out'] = nrm(ks[23], (N_ATTN_LAYERS, HEADS_PER_GROUP * HEAD_DIM, D_MODEL), (HEADS_PER_GROUP * HEAD_DIM) ** -0.5)
    return inp


def reference(x_prompt, x_sample, state_pool, cache_kv_g0, cache_kv_g1, cache_kv_g2,
              norm_ffn1, ffn1_w_in, ffn1_w_out, norm_mix, norm_ffn2, ffn2_w_in, ffn2_w_out,
              pool_w, pool_scale,
              chunk_w_in, chunk_v_norm, chunk_w_s, chunk_b_s, chunk_w_out,
              attn_w_qkv, attn_q_norm, attn_k_norm, attn_w_out):
    caches = (cache_kv_g0, cache_kv_g1, cache_kv_g2)
    xp, xs = x_prompt, x_sample
    pool_p, pool_s, chunk_s = [], [], []
    kv_p = [[] for _ in ATTN_GROUPS]
    kv_s = [[] for _ in ATTN_GROUPS]
    for i in range(DEPTH):
        kind, j = i % N_MIXERS, i // N_MIXERS
        xp = xp + 0.5 * swiglu(rms_norm(xp, norm_ffn1[i]), ffn1_w_in[i], ffn1_w_out[i])
        xs = xs + 0.5 * swiglu(rms_norm(xs, norm_ffn1[i]), ffn1_w_in[i], ffn1_w_out[i])
        hp = rms_norm(xp, norm_mix[i])
        hs = rms_norm(xs, norm_mix[i])
        if kind == 0:
            zero_buf = jnp.zeros((hp.shape[0], POOL_BUF, D_MODEL), hp.dtype)
            mp, st_p = pool_mixer(hp, zero_buf, 0, pool_w[j], pool_scale[j])
            ms, st_s = pool_mixer(hs, state_pool[j], PAST_LEN, pool_w[j], pool_scale[j])
            pool_p.append(st_p)
            pool_s.append(st_s)
        elif kind == 1:
            mp = chunk_mixer_prompt(hp, chunk_w_in[j], chunk_v_norm[j], chunk_w_s[j], chunk_b_s[j], chunk_w_out[j])
            ms, v_new = chunk_mixer_sample(hs, chunk_w_in[j], chunk_v_norm[j], chunk_w_s[j], chunk_b_s[j], chunk_w_out[j])
            chunk_s.append(v_new)
        else:
            mp, rows_p = attn_mixer_prompt(hp, attn_w_qkv[j], attn_q_norm[j], attn_k_norm[j], attn_w_out[j])
            ms, rows_s = attn_mixer_sample(hs, tuple(c[j] for c in caches), attn_w_qkv[j], attn_q_norm[j], attn_k_norm[j], attn_w_out[j])
            for g in range(N_ATTN_GROUPS):
                kv_p[g].append(rows_p[g])
                kv_s[g].append(rows_s[g])
        xp = xp + mp
        xs = xs + ms
        xp = xp + 0.5 * swiglu(rms_norm(xp, norm_ffn2[i]), ffn2_w_in[i], ffn2_w_out[i])
        xs = xs + 0.5 * swiglu(rms_norm(xs, norm_ffn2[i]), ffn2_w_in[i], ffn2_w_out[i])
    return (xp, xs, jnp.stack(pool_p), jnp.stack(pool_s), jnp.stack(chunk_s),
            jnp.stack(kv_p[0]), jnp.stack(kv_s[0]), jnp.stack(kv_p[1]), jnp.stack(kv_s[1]),
            jnp.stack(kv_p[2]), jnp.stack(kv_s[2]))
```

```cpp
#include <hip/hip_runtime.h>
#include <cstdio>
#include <cstdint>

#ifndef MK_N_LAUNCHES
#define MK_N_LAUNCHES 1
#endif

#define GAS __attribute__((address_space(1)))
#define LAS __attribute__((address_space(3)))
typedef unsigned short bf16_t;
typedef short bf16x8 __attribute__((ext_vector_type(8)));
typedef float f32x4 __attribute__((ext_vector_type(4)));
typedef float f32x2 __attribute__((ext_vector_type(2)));
typedef unsigned u32x4 __attribute__((ext_vector_type(4)));
typedef unsigned u32x2 __attribute__((ext_vector_type(2)));

constexpr int D = 2048, FF = 5504, SEQ = 2048, NBATCH = 4, MPR = 8192, MS = 32, MR = 8224, MPAD = 8448;
constexpr int NQKV = 18432, HD = 128, NH = 16, AW = 6144;
constexpr int DEC_B = 8, DEC_T = 4, PAST = 16384;
constexpr float EPS = 1e-6f;
constexpr float QSCALE = 0.08838834764831845f * 1.4426950408889634f;
constexpr float LN2 = 0.6931471805599453f;

constexpr size_t O_YP = 0, O_YS = 16777216, O_PP = 16842752, O_PS = 17088512, O_CV = 17580032, O_K0P = 17645568, O_K0S = 19742720,
                 O_K1P = 19873792, O_K1S = 28262400, O_K2P = 28393472, O_K2S = 61947904, O_END = 62078976;

constexpr size_t MiB = 1u << 20;
constexpr size_t WS_CTL = 0, CTL_ZERO_BYTES = 32 * 1024;
constexpr size_t WS_PART = 1 * MiB, WS_CS = 1 * MiB + 512 * 1024  , WS_VPART = 3 * MiB, WS_LSE = 5 * MiB, WS_WSB = 7 * MiB, WS_SPART = 7 * MiB + 512 * 1024, WS_SVPART = WS_SPART + 16384;
constexpr size_t WS_WIN = 8 * MiB, WIN_BYTES = 43 * MiB;
constexpr size_t WS_WOUT = 352 * MiB, WOUT_BYTES = (size_t)2048 * 5504 * 2;
constexpr size_t WS_WPOOL = 524 * MiB, WPOOL_BYTES = 2 * MiB;
constexpr size_t WS_WCIN = 528 * MiB, WS_WCOUT = 544 * MiB, WS_WQKV = 552 * MiB, WS_WAO = 624 * MiB;
constexpr size_t WS_X = 632 * MiB, WS_XB = 698 * MiB, WS_SCR = 731 * MiB;
constexpr size_t WS_H = WS_SCR, WS_POOLED = WS_SCR, WS_U = WS_SCR, WS_V = WS_SCR + 33 * MiB, WS_Y = WS_SCR + 66 * MiB;
constexpr size_t WS_RAW = WS_SCR, WS_QP = WS_SCR + 297 * MiB, WS_KP = WS_SCR + 396 * MiB, WS_VT = WS_SCR + 495 * MiB, WS_VB = WS_VT  , WS_OG = WS_SCR, WS_OC = WS_SCR + 99 * MiB;
constexpr size_t WS_END = WS_SCR + 594 * MiB;
static_assert(WS_WOUT + 8 * WOUT_BYTES <= WS_WPOOL && WS_WIN + 8 * WIN_BYTES <= WS_WOUT, "ws map");
constexpr int CW_BAR = 4096;
static_assert((CW_BAR + 3456) * 4 <= (int)CTL_ZERO_BYTES, "barrier words inside the per-call memset");

constexpr int RING_BYTES = 131072, TAB_OFF = RING_BYTES, RED_OFF = TAB_OFF + 16384, MISC_OFF = RED_OFF + 4096, STAB_OFF = MISC_OFF + 128, LDS_BYTES = 155648;

#define LDS_WAIT() asm volatile("s_waitcnt lgkmcnt(0)" ::: "memory")
#define VM_WAIT() asm volatile("s_waitcnt vmcnt(0)" ::: "memory")
__device__ __forceinline__ unsigned cvt_pk_bf16(float lo, float hi) { unsigned r; asm volatile("v_cvt_pk_bf16_f32 %0, %1, %2" : "=v"(r) : "v"(lo), "v"(hi)); return r; }
__device__ __forceinline__ float bflo(unsigned w) { return __uint_as_float(w << 16); }
__device__ __forceinline__ float bfhi(unsigned w) { return __uint_as_float(w & 0xffff0000u); }
__device__ __forceinline__ float bf1(bf16_t b) { return __uint_as_float(((unsigned)b) << 16); }
__device__ __forceinline__ float wave_sum(float v) {
#pragma unroll
    for (int o = 1; o < 64; o <<= 1) v += __shfl_xor(v, o);
    return v;
}

namespace pg8 {
constexpr int BM = 256, BK = 64, HALF = 128, HTB = HALF * BK * 2, STAGE_BYTES = 8 * HTB, NXCD = 8, WGM = 4;
__host__ __device__ __forceinline__ int lds_byte(int r, int c) { const int st = (r >> 4) * 2 + (c >> 5), rr = r & 15, cc = c & 31, ob = rr * 64 + cc * 2; return st * 1024 + (ob ^ (((ob >> 9) & 1) << 5)); }
__host__ __device__ __forceinline__ void stage_rc(int b, int& R, int& C) { const int st = b / 1024, sb = b % 1024, swz = sb ^ (((sb >> 9) & 1) << 5); R = (st >> 1) * 16 + swz / 64; C = (st & 1) * 32 + (swz % 64) / 2; }
__host__ __device__ __forceinline__ int perm32(int rho) { const int n = rho >> 4, i = rho & 15; return 8 * (i >> 2) + 4 * n + (i & 3); }

struct Unit { int pm, pn; };
struct Gemm { const bf16_t* A; const bf16_t* Bt; };

struct StaticOrder {
    int nM, nN, nwg, G, c, rep;
    __device__ void init(int nM_, int nN_, int G_, int c_, int rep_ = 1) { nM = nM_; nN = nN_; nwg = nM * nN; G = G_; c = c_; rep = rep_; }
    __device__ bool next(int i, Unit& u) const {
        const long L = (long)(i / rep) * G + c; if (L >= nwg) return false;
        int wgid = (int)L; { const int q = nwg / NXCD, r = nwg % NXCD, xcd = wgid % NXCD, off = wgid / NXCD; wgid = (xcd < r ? xcd * (q + 1) : r * (q + 1) + (xcd - r) * q) + off; }
        const int nig = WGM * nN, gid = wgid / nig, fm = gid * WGM, gsz = (nM - fm) < WGM ? (nM - fm) : WGM;
        u.pm = fm + ((wgid % nig) % gsz); u.pn = (wgid % nig) / gsz; return true;
    }
};

typedef float f32x2v __attribute__((ext_vector_type(2)));
__device__ __forceinline__ f32x2v gelu_pk(f32x2v v) {
    const f32x2v av = __builtin_elementwise_abs(v), d = av * 0.2316418882f + 1.0f;
    f32x2v t; t.x = __builtin_amdgcn_rcpf(d.x); t.y = __builtin_amdgcn_rcpf(d.y);
    f32x2v q = t * 0.5307027145f + (-0.7265760135f); q = q * t + 0.7107068705f; q = q * t + (-0.142248368f); q = q * t + 0.127414796f; q = q * t;
    const f32x2v s = (v * v) * (-0.72134752044f);
    f32x2v e; e.x = __builtin_amdgcn_exp2f(s.x); e.y = __builtin_amdgcn_exp2f(s.y);
    const f32x2v m = v * (q * e), r = v - m;
    f32x2v o; o.x = v.x < 0.f ? m.x : r.x; o.y = v.y < 0.f ? m.y : r.y; return o;
}

__device__ __forceinline__ void rstd_prefetch(const float* part, LAS float* tab, const LAS float* stab, const Unit& u, int par) {
    int tid = threadIdx.x; asm volatile("" : "+v"(tid));
    if (u.pm == MPR / BM) { if (tid < 256) { float z = 0.f; asm volatile("" : "+v"(z));
            LAS f32x4* t4 = (LAS f32x4*)(tab + par * 2048 + tid * 8); t4[0] = (f32x4){tid < 32 ? stab[tid] : z, z, z, z}; t4[1] = (f32x4){z, z, z, z}; } }
    else __builtin_amdgcn_global_load_lds((const unsigned*)(part + (size_t)u.pm * 2048 + tid * 4), (LAS unsigned*)(tab + par * 2048 + (tid >> 6) * 256), 16, 0, 0);
}
__device__ __forceinline__ float tab_rstd(const LAS float* tab, int par, int rl) {
    const LAS f32x4* t4 = (const LAS f32x4*)(tab + par * 2048 + rl * 8); const f32x4 a = t4[0] + t4[1];
    return rsqrtf(((a[0] + a[1]) + (a[2] + a[3])) * (1.0f / 2048.0f) + EPS);
}

struct EpiSwiglu {
    static constexpr bool PERM = true, INIT_ACC = false;
    bf16_t* H; const float* part; LAS float* tab; const LAS float* stab;
    __device__ __forceinline__ void prefetch(const Unit& u, int par) const { rstd_prefetch(part, tab, stab, u, par); }
    __device__ __forceinline__ void operator()(const f32x4 (&acc)[2][2][4][2], const Unit& u, int par, int wr, int wc, int fr, int fq) const {
        const int col0 = u.pn * 128 + wc * 32 + 8 * fq;
#pragma unroll
        for (int ai = 0; ai < 2; ++ai)
#pragma unroll
            for (int m = 0; m < 4; ++m) {
                const int rl = ai * HALF + wr * 64 + m * 16 + fr; const float rs = tab_rstd(tab, par, rl);
                float o[8];
#pragma unroll
                for (int n = 0; n < 2; ++n)
#pragma unroll
                    for (int j = 0; j < 4; ++j) { const float g = acc[ai][0][m][n][j] * rs, up = acc[ai][1][m][n][j] * rs;
                        const float e = __builtin_amdgcn_exp2f(g * -1.4426950408889634f); o[n * 4 + j] = g * up * __builtin_amdgcn_rcpf(1.0f + e); }
                u32x4 w; w.x = cvt_pk_bf16(o[0], o[1]); w.y = cvt_pk_bf16(o[2], o[3]); w.z = cvt_pk_bf16(o[4], o[5]); w.w = cvt_pk_bf16(o[6], o[7]);
                *(u32x4*)(H + (size_t)(u.pm * BM + rl) * FF + col0) = w;
            }
    }
};
template <bool INIT> struct EpiResT {
    static constexpr bool PERM = true, INIT_ACC = INIT;
    float* X; bf16_t* XB; float* part; float* OUT; const float* scale; const float* gnext; LAS float* red; float factor; int probe2 = 0;
    __device__ __forceinline__ void prefetch(const Unit&, int) const {}
    __device__ __forceinline__ void init(f32x4 (&acc)[2][2][4][2], const Unit& u, int wr, int wc, int fr, int fq) const {
        const int col0 = u.pn * BM + wc * 32 + 8 * fq; const float inv = 1.0f / factor;
#pragma unroll
        for (int ai = 0; ai < 2; ++ai)
#pragma unroll
            for (int m = 0; m < 4; ++m)
#pragma unroll
                for (int bj = 0; bj < 2; ++bj)
#pragma unroll
                    for (int n = 0; n < 2; ++n)
                        acc[ai][bj][m][n] = *(const f32x4*)(X + (size_t)(u.pm * BM + ai * HALF + wr * 64 + m * 16 + fr) * D + col0 + bj * HALF + 4 * n) * inv;
    }
    __device__ __forceinline__ void operator()(const f32x4 (&acc)[2][2][4][2], const Unit& u, int par, int wr, int wc, int fr, int fq) const {
        const int col0 = u.pn * BM + wc * 32 + 8 * fq;
        f32x4 gn[2][2], sc[2][2];
#pragma unroll
        for (int bj = 0; bj < 2; ++bj)
#pragma unroll
            for (int n = 0; n < 2; ++n) { const int c = col0 + bj * HALF + 4 * n; gn[bj][n] = gnext ? *(const f32x4*)(gnext + c) : (f32x4){1.f, 1.f, 1.f, 1.f};
                sc[bj][n] = (scale ? *(const f32x4*)(scale + c) : (f32x4){1.f, 1.f, 1.f, 1.f}) * ((probe2 && par == 0) ? 0.f : factor); }
#pragma unroll
        for (int ai = 0; ai < 2; ++ai)
#pragma unroll
            for (int m = 0; m < 4; ++m) {
                const int rl = ai * HALF + wr * 64 + m * 16 + fr, row = u.pm * BM + rl; float ss = 0.f;
#pragma unroll
                for (int bj = 0; bj < 2; ++bj) { const size_t off = (size_t)row * D + col0 + bj * HALF;
                    const f32x4 a0 = acc[ai][bj][m][0] * sc[bj][0], a1 = acc[ai][bj][m][1] * sc[bj][1];
                    const f32x4 x0 = INIT ? a0 : *(const f32x4*)(X + off) + a0, x1 = INIT ? a1 : *(const f32x4*)(X + off + 4) + a1;
                    *(f32x4*)(X + off) = x0; *(f32x4*)(X + off + 4) = x1; if (OUT && row < MR) { *(f32x4*)(OUT + off) = x0; *(f32x4*)(OUT + off + 4) = x1; }
                    const f32x4 g0 = x0 * gn[bj][0], g1 = x1 * gn[bj][1];
                    u32x4 w; w.x = cvt_pk_bf16(g0[0], g0[1]); w.y = cvt_pk_bf16(g0[2], g0[3]); w.z = cvt_pk_bf16(g1[0], g1[1]); w.w = cvt_pk_bf16(g1[2], g1[3]); *(u32x4*)(XB + off) = w;
                    ss += ((x0[0] * x0[0] + x0[1] * x0[1]) + (x0[2] * x0[2] + x0[3] * x0[3])) + ((x1[0] * x1[0] + x1[1] * x1[1]) + (x1[2] * x1[2] + x1[3] * x1[3])); }
                ss += __shfl_xor(ss, 16); ss += __shfl_xor(ss, 32);
                if (fq == 0) red[rl * 4 + wc] = ss;
                asm volatile("" ::: "memory");
            }
        asm volatile("s_waitcnt lgkmcnt(0)" ::: "memory"); __builtin_amdgcn_s_barrier(); asm volatile("" ::: "memory");
        if (threadIdx.x < 256) { const f32x4 r4 = *(const LAS f32x4*)(red + threadIdx.x * 4); part[(size_t)(u.pm * BM + threadIdx.x) * 8 + u.pn] = (r4[0] + r4[1]) + (r4[2] + r4[3]); }
    }
};
typedef EpiResT<false> EpiRes;
struct EpiGelu {
    static constexpr bool PERM = true, INIT_ACC = false;
    bf16_t* U; bf16_t* V; float* vpart; const float* part; LAS float* tab; const LAS float* stab;
    __device__ __forceinline__ void prefetch(const Unit& u, int par) const { rstd_prefetch(part, tab, stab, u, par); }
    __device__ __forceinline__ void operator()(const f32x4 (&acc)[2][2][4][2], const Unit& u, int par, int wr, int wc, int fr, int fq) const {
        const bool isv = u.pn >= 8; bf16_t* O = isv ? V : U; const int col0 = (u.pn & 7) * BM + wc * 32 + 8 * fq;
#pragma unroll
        for (int ai = 0; ai < 2; ++ai)
#pragma unroll
            for (int m = 0; m < 4; ++m) {
                const int rl = ai * HALF + wr * 64 + m * 16 + fr; const float rs = tab_rstd(tab, par, rl); float ss = 0.f;
#pragma unroll
                for (int bj = 0; bj < 2; ++bj) {
                    const f32x4 v0 = acc[ai][bj][m][0] * rs, v1 = acc[ai][bj][m][1] * rs;
                    const f32x2v a = gelu_pk((f32x2v){v0[0], v0[1]}), b = gelu_pk((f32x2v){v0[2], v0[3]}), c = gelu_pk((f32x2v){v1[0], v1[1]}), d = gelu_pk((f32x2v){v1[2], v1[3]});
                    ss += (a.x * a.x + a.y * a.y) + (b.x * b.x + b.y * b.y) + (c.x * c.x + c.y * c.y) + (d.x * d.x + d.y * d.y);
                    u32x4 w; w.x = cvt_pk_bf16(a.x, a.y); w.y = cvt_pk_bf16(b.x, b.y); w.z = cvt_pk_bf16(c.x, c.y); w.w = cvt_pk_bf16(d.x, d.y);
                    *(u32x4*)(O + (size_t)(u.pm * BM + rl) * D + col0 + bj * HALF) = w; }
                if (isv) { ss += __shfl_xor(ss, 16); ss += __shfl_xor(ss, 32); if (fq == 0) vpart[(size_t)(u.pm * BM + rl) * 32 + (u.pn - 8) * 4 + wc] = ss; }
            }
    }
};
struct EpiQKV {
    static constexpr bool PERM = true, INIT_ACC = false;
    bf16_t* QP; bf16_t* KP; bf16_t* VB; float* out; const float* cs; const float* qg; const float* kg; const float* part; LAS float* tab; const LAS float* stab; LAS float* red;
    __device__ __forceinline__ void prefetch(const Unit& u, int par) const { rstd_prefetch(part, tab, stab, u, par); }
    __device__ __forceinline__ float* kv_out(int row, int g, int kv) const {
        const int keep = g == 0 ? 128 : (g == 1 ? 512 : 2048);
        if (row < MPR) { const int t = row & (SEQ - 1), b = row >> 11; if (t < SEQ - keep) return nullptr;
            return out + (g == 0 ? O_K0P : (g == 1 ? O_K1P : O_K2P)) + ((size_t)(b * keep + (t - (SEQ - keep))) * 2 + kv) * 2048; }
        if (row < MR) return out + (g == 0 ? O_K0S : (g == 1 ? O_K1S : O_K2S)) + ((size_t)(row - MPR) * 2 + kv) * 2048;
        return nullptr;
    }
    __device__ __forceinline__ void operator()(const f32x4 (&acc)[2][2][4][2], const Unit& u, int par, int wr, int wc, int fr, int fq) const {
        const int s = u.pn / 24, g = (u.pn % 24) >> 3, hp = u.pn & 7;
        if (s == 2) {
#pragma unroll
            for (int ai = 0; ai < 2; ++ai)
#pragma unroll
                for (int m = 0; m < 4; ++m) {
                    const int rl = ai * HALF + wr * 64 + m * 16 + fr, row = u.pm * BM + rl; const float rs = tab_rstd(tab, par, rl);
                    float* ov = kv_out(row, g, 1);
#pragma unroll
                    for (int bj = 0; bj < 2; ++bj) {
                        const f32x4 v0 = acc[ai][bj][m][0] * rs, v1 = acc[ai][bj][m][1] * rs; const int col = g * 2048 + (2 * hp + bj) * 128 + wc * 32 + 8 * fq;
                        u32x4 w; w.x = cvt_pk_bf16(v0[0], v0[1]); w.y = cvt_pk_bf16(v0[2], v0[3]); w.z = cvt_pk_bf16(v1[0], v1[1]); w.w = cvt_pk_bf16(v1[2], v1[3]);
                        *(u32x4*)(VB + (size_t)row * AW + col) = w;
                        if (ov) { float* o = ov + (2 * hp + bj) * 128 + wc * 32 + 8 * fq; *(f32x4*)o = (f32x4){bflo(w.x), bfhi(w.x), bflo(w.y), bfhi(w.y)}; *(f32x4*)(o + 4) = (f32x4){bflo(w.z), bfhi(w.z), bflo(w.w), bfhi(w.w)}; }
                    }
                }
            return;
        }
#pragma unroll
        for (int ai = 0; ai < 2; ++ai)
#pragma unroll
            for (int m = 0; m < 4; ++m) {
                const int rl = ai * HALF + wr * 64 + m * 16 + fr; const float rs = tab_rstd(tab, par, rl); float ss = 0.f;
#pragma unroll
                for (int bj = 0; bj < 2; ++bj)
#pragma unroll
                    for (int n = 0; n < 2; ++n) { const f32x4 x = acc[ai][bj][m][n] * rs; ss += (x[0] * x[0] + x[1] * x[1]) + (x[2] * x[2] + x[3] * x[3]); }
                ss += __shfl_xor(ss, 16); ss += __shfl_xor(ss, 32);
                if (fq == 0) red[rl * 4 + wc] = ss;
            }
        asm volatile("s_waitcnt lgkmcnt(0)" ::: "memory"); __builtin_amdgcn_s_barrier(); asm volatile("" ::: "memory");
        const float* gain = s == 0 ? qg : kg; const int e1 = 32 * (wc & 1) + 8 * fq, head = 2 * hp + (wc >> 1);
        const f32x4 g1a = *(const f32x4*)(gain + e1), g1b = *(const f32x4*)(gain + e1 + 4), g2a = *(const f32x4*)(gain + 64 + e1), g2b = *(const f32x4*)(gain + 64 + e1 + 4);
        const float osc = s == 0 ? QSCALE : 1.0f; bf16_t* dstb = (s == 0 ? QP : KP) + g * 2048 + head * 128 + e1;
#pragma unroll
        for (int aim = 0; aim < 4; ++aim) { const int ai = aim >> 1, m0 = (aim & 1) * 2;
            f32x4 tca[2], tcb[2], tsa[2], tsb[2];
#pragma unroll
            for (int mm = 0; mm < 2; ++mm) { const int row = u.pm * BM + ai * HALF + wr * 64 + (m0 + mm) * 16 + fr;
                const int pi = row < MPR ? (row & (SEQ - 1)) : (row < MR ? SEQ + ((row - MPR) & 3) : 0); const float* cp = cs + (size_t)pi * 128 + e1;
                tca[mm] = *(const f32x4*)cp; tcb[mm] = *(const f32x4*)(cp + 4); tsa[mm] = *(const f32x4*)(cp + 64); tsb[mm] = *(const f32x4*)(cp + 68); }
            asm volatile("" ::: "memory");
#pragma unroll
            for (int mm = 0; mm < 2; ++mm) { const int m = m0 + mm;
                const int rl = ai * HALF + wr * 64 + m * 16 + fr, row = u.pm * BM + rl; const float rs = tab_rstd(tab, par, rl);
                const float tot = red[rl * 4 + (wc & 2)] + red[rl * 4 + (wc | 1)]; const float f = rs * rsqrtf(tot * (1.0f / 128.0f) + EPS);
                const f32x4 ca = tca[mm], cb = tcb[mm], sa = tsa[mm], sb = tsb[mm];
                const f32x4 y1a = acc[ai][0][m][0] * f * g1a, y1b = acc[ai][0][m][1] * f * g1b, y2a = acc[ai][1][m][0] * f * g2a, y2b = acc[ai][1][m][1] * f * g2b;
                const f32x4 o1a = y1a * ca - y2a * sa, o1b = y1b * cb - y2b * sb, o2a = y1a * sa + y2a * ca, o2b = y1b * sb + y2b * cb;
                u32x4 w1, w2;
                w1.x = cvt_pk_bf16(o1a[0] * osc, o1a[1] * osc); w1.y = cvt_pk_bf16(o1a[2] * osc, o1a[3] * osc); w1.z = cvt_pk_bf16(o1b[0] * osc, o1b[1] * osc); w1.w = cvt_pk_bf16(o1b[2] * osc, o1b[3] * osc);
                w2.x = cvt_pk_bf16(o2a[0] * osc, o2a[1] * osc); w2.y = cvt_pk_bf16(o2a[2] * osc, o2a[3] * osc); w2.z = cvt_pk_bf16(o2b[0] * osc, o2b[1] * osc); w2.w = cvt_pk_bf16(o2b[2] * osc, o2b[3] * osc);
                *(u32x4*)(dstb + (size_t)row * AW) = w1; *(u32x4*)(dstb + (size_t)row * AW + 64) = w2;
                if (s == 1) { float* ok = kv_out(row, g, 0);
                    if (ok) { ok += head * 128 + e1; *(f32x4*)ok = o1a; *(f32x4*)(ok + 4) = o1b; *(f32x4*)(ok + 64) = o2a; *(f32x4*)(ok + 68) = o2b; } }
            }
        }
    }
};

template <class Epi, int LDA, int LDB, int KK, int AGS, bool ALIGN_EPI, bool SP2>
__device__ __forceinline__ void gemm_phase(LAS unsigned char* lds, const Gemm g, const StaticOrder& S, const Epi& E) {
    int tid = threadIdx.x; asm volatile("" : "+v"(tid));
    const int wid = __builtin_amdgcn_readfirstlane(tid >> 6), lane = tid & 63, wr = wid >> 2, wc = wid & 3, fr = lane & 15, fq = lane >> 4;
    constexpr int nt = KK / BK;
    unsigned voffA[2], voffB[2];
#pragma unroll
    for (int i = 0; i < 2; ++i) { int R, C; stage_rc(tid * 16 + i * 8192, R, C); const int Rb = Epi::PERM ? ((R & ~31) + perm32(R & 31)) : R;
        voffA[i] = (unsigned)(R * LDA + C) * 2u; voffB[i] = (unsigned)(Rb * LDB + C) * 2u; }
    constexpr size_t kstep = (size_t)(BK * 2);
    constexpr size_t hstepA = (size_t)HALF * LDA * 2, hstepB = (size_t)HALF * LDB * 2;
    constexpr size_t tstepA = 2 * hstepA, tstepB = 2 * hstepB;
    const unsigned ldsw = (unsigned)wid * 1024u;
    const int aoff = lds_byte(wr * 64 + fr, fq * 8), boff = lds_byte(wc * 32 + fr, fq * 8);
#define PG8_UA(u) ((const char*)g.A + (size_t)(u).pm * tstepA + (AGS ? (size_t)((u).pn >> 1) * (size_t)AGS * 2 : (size_t)0))
#define PG8_UB(u) ((const char*)g.Bt + (size_t)(u).pn * tstepB)
#define PG8_SA(b, h) (((b) * 2 + (h)) * HTB)
#define PG8_SB(b, h) ((4 + (b) * 2 + (h)) * HTB)
#define PG8_STAGE(bufoff, gbase, voff) do { _Pragma("unroll") for (int _i = 0; _i < 2; ++_i) \
        __builtin_amdgcn_global_load_lds((const unsigned*)((const char*)(gbase) + (voff)[_i]), (LAS unsigned*)(lds + (bufoff) + ldsw + _i * 8192), 16, 0, 0); } while (0)
#define PG8_LDA(dst, b, h) do { _Pragma("unroll") for (int m = 0; m < 4; ++m) _Pragma("unroll") for (int k = 0; k < 2; ++k) dst[m][k] = *(const LAS bf16x8*)(lds + PG8_SA(b, h) + aoff + m * 2048 + k * 1024); } while (0)
#define PG8_LDB(dst, b, h) do { _Pragma("unroll") for (int n = 0; n < 2; ++n) _Pragma("unroll") for (int k = 0; k < 2; ++k) dst[n][k] = *(const LAS bf16x8*)(lds + PG8_SB(b, h) + boff + n * 2048 + k * 1024); } while (0)
#define PG8_MMA(ai, bj, At, Bt) do { __builtin_amdgcn_s_setprio(1); _Pragma("unroll") for (int m = 0; m < 4; ++m) _Pragma("unroll") for (int n = 0; n < 2; ++n) _Pragma("unroll") for (int k = 0; k < 2; ++k) \
        acc[ai][bj][m][n] = __builtin_amdgcn_mfma_f32_16x16x32_bf16(Bt[n][k], At[m][k], acc[ai][bj][m][n], 0, 0, 0); __builtin_amdgcn_s_setprio(0); } while (0)
#define PG8_WAIT_V(n) asm volatile("s_waitcnt vmcnt(" #n ")" ::: "memory")
#define PG8_WAIT_L(n) asm volatile("s_waitcnt lgkmcnt(" #n ")" ::: "memory")
#define PG8_BAR __builtin_amdgcn_s_barrier()
#define PG8_SCHED __builtin_amdgcn_sched_barrier(0)
    Unit cur, nxt; int ui = 0;
    if (!S.next(0, cur)) return;
    f32x4 acc[2][2][4][2];
#pragma unroll
    for (int a = 0; a < 2; ++a)
#pragma unroll
        for (int b = 0; b < 2; ++b)
#pragma unroll
            for (int m = 0; m < 4; ++m)
#pragma unroll
                for (int n = 0; n < 2; ++n) acc[a][b][m][n] = (f32x4){0.f, 0.f, 0.f, 0.f};
    if constexpr (Epi::INIT_ACC) E.init(acc, cur, wr, wc, fr, fq);
    bf16x8 At[4][2], B0[2][2], B1[2][2];
    const char* cA = PG8_UA(cur); const char* cB = PG8_UB(cur);
    E.prefetch(cur, 0);
    if constexpr (SP2) {
        PG8_STAGE(PG8_SB(0, 0), cB, voffB); PG8_STAGE(PG8_SB(0, 1), cB + hstepB, voffB); PG8_STAGE(PG8_SA(0, 0), cA, voffA); PG8_STAGE(PG8_SA(0, 1), cA + hstepA, voffA);
        if (wr == 1) PG8_BAR;
        PG8_WAIT_V(2); PG8_BAR;
        PG8_STAGE(PG8_SB(1, 0), cB + kstep, voffB); PG8_STAGE(PG8_SA(1, 0), cA + kstep, voffA); PG8_STAGE(PG8_SB(1, 1), cB + hstepB + kstep, voffB);
        PG8_WAIT_V(6); PG8_BAR;
    } else {
        PG8_STAGE(PG8_SB(0, 0), cB, voffB); PG8_STAGE(PG8_SA(0, 0), cA, voffA); PG8_STAGE(PG8_SB(0, 1), cB + hstepB, voffB); PG8_STAGE(PG8_SA(0, 1), cA + hstepA, voffA);
        if (wr == 1) PG8_BAR;
        PG8_WAIT_V(4); PG8_BAR;
        PG8_STAGE(PG8_SB(1, 0), cB + kstep, voffB); PG8_STAGE(PG8_SA(1, 0), cA + kstep, voffA); PG8_STAGE(PG8_SB(1, 1), cB + hstepB + kstep, voffB);
        PG8_WAIT_V(6); PG8_BAR;
    }
    for (;;) {
        const bool has_next = S.next(ui + 1, nxt);
        const char* nA = has_next ? PG8_UA(nxt) : cA; const char* nB = has_next ? PG8_UB(nxt) : cB;
        for (int t = 0; t < nt; t += 2) {
            const bool last = (t == nt - 2);
            const char* a1 = cA + (size_t)(t + 1) * kstep;
            const char* a2 = last ? nA : cA + (size_t)(t + 2) * kstep; const char* b2 = last ? nB : cB + (size_t)(t + 2) * kstep;
            const char* a3 = a2 + kstep; const char* b3 = b2 + kstep;
            if (last && has_next) E.prefetch(nxt, (ui + 1) & 1);
            if constexpr (SP2) {
            PG8_LDB(B0, 0, 0); PG8_LDB(B1, 0, 1); PG8_SCHED; PG8_LDA(At, 0, 0); PG8_STAGE(PG8_SA(1, 1), a1 + hstepA, voffA);
            PG8_WAIT_V(8); PG8_WAIT_L(0); PG8_BAR; PG8_MMA(0, 0, At, B0); PG8_MMA(0, 1, At, B1); PG8_BAR; PG8_SCHED;
            PG8_LDA(At, 0, 1); PG8_STAGE(PG8_SB(0, 0), b2, voffB); PG8_STAGE(PG8_SB(0, 1), b2 + hstepB, voffB); PG8_STAGE(PG8_SA(0, 0), a2, voffA);
            PG8_WAIT_V(8); PG8_WAIT_L(0); PG8_BAR; PG8_MMA(1, 0, At, B0); PG8_MMA(1, 1, At, B1); PG8_BAR; PG8_SCHED;
            PG8_LDB(B0, 1, 0); PG8_LDB(B1, 1, 1); PG8_SCHED; PG8_LDA(At, 1, 0); PG8_STAGE(PG8_SA(0, 1), a2 + hstepA, voffA);
            PG8_WAIT_V(8); PG8_WAIT_L(0); PG8_BAR; PG8_MMA(0, 0, At, B0); PG8_MMA(0, 1, At, B1); PG8_BAR; PG8_SCHED;
            PG8_LDA(At, 1, 1); PG8_STAGE(PG8_SB(1, 0), b3, voffB); PG8_STAGE(PG8_SB(1, 1), b3 + hstepB, voffB); PG8_STAGE(PG8_SA(1, 0), a3, voffA);
            PG8_WAIT_V(8); PG8_WAIT_L(0); PG8_BAR; PG8_MMA(1, 0, At, B0); PG8_MMA(1, 1, At, B1); PG8_BAR; PG8_SCHED;
            } else {
            PG8_LDB(B0, 0, 0); PG8_SCHED; PG8_LDA(At, 0, 0); PG8_STAGE(PG8_SA(1, 1), a1 + hstepA, voffA);
            PG8_WAIT_L(8); PG8_BAR; PG8_WAIT_L(0); PG8_MMA(0, 0, At, B0); PG8_BAR; PG8_SCHED;
            PG8_LDB(B1, 0, 1); PG8_STAGE(PG8_SB(0, 0), b2, voffB);
            PG8_BAR; PG8_WAIT_L(0); PG8_MMA(0, 1, At, B1); PG8_BAR;
            PG8_LDA(At, 0, 1); PG8_STAGE(PG8_SA(0, 0), a2, voffA);
            PG8_BAR; PG8_WAIT_L(0); PG8_MMA(1, 0, At, B0); PG8_BAR; PG8_SCHED;
            PG8_STAGE(PG8_SB(0, 1), b2 + hstepB, voffB);
            PG8_WAIT_V(6); PG8_BAR; PG8_MMA(1, 1, At, B1); PG8_BAR;
            PG8_LDB(B0, 1, 0); PG8_SCHED; PG8_LDA(At, 1, 0); PG8_STAGE(PG8_SA(0, 1), a2 + hstepA, voffA);
            PG8_WAIT_L(8); PG8_BAR; PG8_WAIT_L(0); PG8_MMA(0, 0, At, B0); PG8_BAR; PG8_SCHED;
            PG8_LDB(B1, 1, 1); PG8_STAGE(PG8_SB(1, 0), b3, voffB);
            PG8_BAR; PG8_WAIT_L(0); PG8_MMA(0, 1, At, B1); PG8_BAR;
            PG8_LDA(At, 1, 1); PG8_STAGE(PG8_SA(1, 0), a3, voffA);
            PG8_BAR; PG8_WAIT_L(0); PG8_MMA(1, 0, At, B0); PG8_BAR; PG8_SCHED;
            PG8_STAGE(PG8_SB(1, 1), b3 + hstepB, voffB);
            PG8_WAIT_V(6); PG8_BAR; PG8_MMA(1, 1, At, B1); PG8_BAR;
            }
        }
        if constexpr (ALIGN_EPI) { if (wr == 0) PG8_BAR; }
        { int t2 = threadIdx.x; asm volatile("" : "+v"(t2));
          E(acc, cur, ui & 1, wr, wc, t2 & 15, (t2 >> 4) & 3); }
        if (!has_next) break;
#pragma unroll
        for (int a = 0; a < 2; ++a)
#pragma unroll
            for (int b = 0; b < 2; ++b)
#pragma unroll
                for (int m = 0; m < 4; ++m)
#pragma unroll
                    for (int n = 0; n < 2; ++n) acc[a][b][m][n] = (f32x4){0.f, 0.f, 0.f, 0.f};
        if constexpr (Epi::INIT_ACC) E.init(acc, nxt, wr, wc, fr, fq);
        cur = nxt; cA = nA; cB = nB; ++ui;
        if constexpr (ALIGN_EPI) { if (wr == 1) PG8_BAR; }
    }
    PG8_WAIT_V(0);
    if constexpr (!ALIGN_EPI) { if (wr == 0) PG8_BAR; }
    PG8_BAR;
#undef PG8_UA
#undef PG8_UB
#undef PG8_SA
#undef PG8_SB
#undef PG8_STAGE
#undef PG8_LDA
#undef PG8_LDB
#undef PG8_MMA
#undef PG8_WAIT_V
#undef PG8_WAIT_L
#undef PG8_BAR
#undef PG8_SCHED
}
}

#ifndef PG8_SP2
#define PG8_SP2 true
#endif
#ifndef PG8_ALIGN
#define PG8_ALIGN true
#endif

template <int LDA, int LDB, int KK, int AGS>
__device__ __forceinline__ void skinny_out(LAS unsigned char* lds, int ct, int wave, int lane, const bf16_t* A, const bf16_t* Bt, float* X, bf16_t* XB, float* OUT, const float* scale, const float* gnext, float factor, float* spart) {
    if (ct >= 128) return;
    const int fr = lane & 15, fq = lane >> 4;
    const bf16_t* Ab = A + (size_t)MPR * LDA + (AGS ? (ct >> 5) * AGS : 0) + (size_t)fr * LDA + 8 * fq;
    const bf16_t* Wb = Bt + (size_t)(16 * ct + fr) * LDB + 8 * fq;
    f32x4 acc0 = (f32x4){0.f, 0.f, 0.f, 0.f}, acc1 = acc0;
    constexpr int NK = KK / 32, PER = (NK + 7) / 8, UB = PER < 11 ? PER : 11;
#pragma unroll
    for (int b0 = 0; b0 < PER; b0 += UB) {
        bf16x8 xf[UB], y0[UB], y1[UB];
#pragma unroll
        for (int u = 0; u < UB; ++u) { const int i = b0 + u;
            if (i < PER) { const int ks = wave + 8 * i; const bool ok = (8 * i + 7 < NK) || ks < NK; const int kc = ok ? ks : 0;
                xf[u] = *(const bf16x8*)(Wb + 32 * kc); y0[u] = *(const bf16x8*)(Ab + 32 * kc); y1[u] = *(const bf16x8*)(Ab + (size_t)16 * LDA + 32 * kc);
                if (8 * i + 7 >= NK) { if (!ok) xf[u] = (bf16x8){0, 0, 0, 0, 0, 0, 0, 0}; } } }
        asm volatile("s_waitcnt vmcnt(0)" ::: "memory");
#pragma unroll
        for (int u = 0; u < UB; ++u) { if (b0 + u < PER) {
            acc0 = __builtin_amdgcn_mfma_f32_16x16x32_bf16(xf[u], y0[u], acc0, 0, 0, 0); acc1 = __builtin_amdgcn_mfma_f32_16x16x32_bf16(xf[u], y1[u], acc1, 0, 0, 0); } }
    }
    LAS f32x4* red2 = (LAS f32x4*)lds;
    red2[(wave * 2 + 0) * 64 + lane] = acc0; red2[(wave * 2 + 1) * 64 + lane] = acc1;
    __syncthreads();
    if (wave < 2) {
        f32x4 a = red2[(0 * 2 + wave) * 64 + lane];
#pragma unroll
        for (int w = 1; w < 8; ++w) a += red2[(w * 2 + wave) * 64 + lane];
        const int row = MPR + 16 * wave + fr, c = 16 * ct + 4 * fq; const size_t off = (size_t)row * D + c;
        a = a * factor; if (scale) a = a * *(const f32x4*)(scale + c);
        const f32x4 xn = *(const f32x4*)(X + off) + a;
        *(f32x4*)(X + off) = xn; if (OUT) *(f32x4*)(OUT + off) = xn;
        f32x4 xg = xn; if (gnext) xg = xg * *(const f32x4*)(gnext + c);
        u32x2 w2; w2.x = cvt_pk_bf16(xg[0], xg[1]); w2.y = cvt_pk_bf16(xg[2], xg[3]); *(u32x2*)(XB + off) = w2;
        float ss = (xn[0] * xn[0] + xn[1] * xn[1]) + (xn[2] * xn[2] + xn[3] * xn[3]);
        ss += __shfl_xor(ss, 16); ss += __shfl_xor(ss, 32);
        if (fq == 0) spart[(size_t)(16 * wave + fr) * 128 + ct] = ss;
    }
    __syncthreads();
}
__device__ __forceinline__ void skinny_cin(LAS unsigned char* lds, int ct, int wave, int lane, const bf16_t* XBp, const bf16_t* Wc, bf16_t* U, bf16_t* V, float* svpart, const LAS float* stab) {
    if (ct >= 256) return;
    const int fr = lane & 15, fq = lane >> 4;
    const bf16_t* Ab = XBp + (size_t)MPR * D + (size_t)fr * D + 8 * fq;
    const bf16_t* Wb = Wc + (size_t)(16 * ct + fr) * D + 8 * fq;
    f32x4 acc0 = (f32x4){0.f, 0.f, 0.f, 0.f}, acc1 = acc0;
    bf16x8 xf[8], y0[8], y1[8];
#pragma unroll
    for (int u = 0; u < 8; ++u) { const int ks = wave + 8 * u; xf[u] = *(const bf16x8*)(Wb + 32 * ks); y0[u] = *(const bf16x8*)(Ab + 32 * ks); y1[u] = *(const bf16x8*)(Ab + (size_t)16 * D + 32 * ks); }
    asm volatile("s_waitcnt vmcnt(0)" ::: "memory");
#pragma unroll
    for (int u = 0; u < 8; ++u) { acc0 = __builtin_amdgcn_mfma_f32_16x16x32_bf16(xf[u], y0[u], acc0, 0, 0, 0); acc1 = __builtin_amdgcn_mfma_f32_16x16x32_bf16(xf[u], y1[u], acc1, 0, 0, 0); }
    LAS f32x4* red2 = (LAS f32x4*)lds;
    red2[(wave * 2 + 0) * 64 + lane] = acc0; red2[(wave * 2 + 1) * 64 + lane] = acc1;
    __syncthreads();
    if (wave < 2) {
        f32x4 a = red2[(0 * 2 + wave) * 64 + lane];
#pragma unroll
        for (int w = 1; w < 8; ++w) a += red2[(w * 2 + wave) * 64 + lane];
        const int rl = 16 * wave + fr; const float rs = rsqrtf(stab[rl] * (1.0f / 2048.0f) + EPS);
        a = a * rs;
        const pg8::f32x2v p = pg8::gelu_pk((pg8::f32x2v){a[0], a[1]}), q = pg8::gelu_pk((pg8::f32x2v){a[2], a[3]});
        const bool isv = ct >= 128; const int c = (16 * ct + 4 * fq) & (D - 1);
        u32x2 w2; w2.x = cvt_pk_bf16(p.x, p.y); w2.y = cvt_pk_bf16(q.x, q.y);
        *(u32x2*)((isv ? V : U) + (size_t)(MPR + rl) * D + c) = w2;
        float ss = (p.x * p.x + p.y * p.y) + (q.x * q.x + q.y * q.y);
        ss += __shfl_xor(ss, 16); ss += __shfl_xor(ss, 32);
        if (isv && fq == 0) svpart[(size_t)rl * 128 + (ct - 128)] = ss;
    }
    __syncthreads();
}
__device__ __forceinline__ void sample_stats(const float* spart, LAS float* stab, int tid) {
    asm volatile("" : "+v"(tid));
    const int row = tid >> 4, sub = tid & 15; const f32x4* p = (const f32x4*)(spart + (size_t)row * 128 + sub * 8);
    const f32x4 a = p[0] + p[1]; float s = (a[0] + a[1]) + (a[2] + a[3]);
    s += __shfl_xor(s, 1); s += __shfl_xor(s, 2); s += __shfl_xor(s, 4); s += __shfl_xor(s, 8);
    if (sub == 0) stab[row] = s;
    __syncthreads();
}

#define XB_TMO      128
#define XB_XCNT(j)  (256  + 64 * (j))
#define XB_XSUB(j)  (1280 + 64 * (j))
#define XB_XGEN(j)  (2304 + 64 * (j))
#define XB_TOP      3328
#define XB_TOPGEN   3392
#define XCD_BAR_WORDS 3456
#define XB_SPIN_CAP (1u << 18)
__device__ __forceinline__ unsigned xb_ld(unsigned* p)              { return __hip_atomic_load(p, __ATOMIC_RELAXED, __HIP_MEMORY_SCOPE_AGENT); }
__device__ __forceinline__ unsigned xb_add(unsigned* p, unsigned v) { return __hip_atomic_fetch_add(p, v, __ATOMIC_RELAXED, __HIP_MEMORY_SCOPE_AGENT); }
__device__ __forceinline__ unsigned xb_xcc_id() { return (unsigned)__builtin_amdgcn_s_getreg((3 << 11) | 20) & 0xFu; }
#define XB_SPIN(cond, bar) do { unsigned _sp = 0; while (cond) { __builtin_amdgcn_s_sleep(1); \
    if ((++_sp & 255u) == 0u) { if (xb_ld(&(bar)[XB_TMO])) break; if (_sp > XB_SPIN_CAP) { atomicAdd(&(bar)[XB_TMO], 1u); break; } } } } while (0)
struct XcdBarrier { unsigned* bar; unsigned x; volatile LAS unsigned* st; };
__device__ __forceinline__ XcdBarrier xcd_barrier_post(unsigned* bar, volatile LAS unsigned* st) {
    XcdBarrier b; b.bar = bar; b.x = xb_xcc_id(); b.st = st;
    if (threadIdx.x == 0) (void)xb_add(&bar[XB_XCNT(b.x)], 1u);
    return b;
}
__device__ __forceinline__ void xcd_barrier_complete(unsigned* bar, unsigned x, unsigned& nloc, unsigned& nx) {
    const unsigned G = gridDim.x * gridDim.y * gridDim.z;
    unsigned sum, cnt, mine, sp = 0u;
    for (;;) {
        sum = 0u; cnt = 0u; mine = 0u;
#pragma unroll
        for (unsigned j = 0; j < 16; ++j) { const unsigned c = xb_ld(&bar[XB_XCNT(j)]); sum += c; cnt += (c > 0u) ? 1u : 0u; mine = (j == x) ? c : mine; }
        if (sum == G) break;
        __builtin_amdgcn_s_sleep(1);
        if ((++sp & 255u) == 0u) { if (xb_ld(&bar[XB_TMO])) break; if (sp > XB_SPIN_CAP) { atomicAdd(&bar[XB_TMO], 1u); break; } }
    }
    nloc = mine > 0u ? mine : 1u; nx = cnt > 0u ? cnt : 1u;
}
__device__ __forceinline__ void xcd_barrier(const XcdBarrier& b) {
    asm volatile("s_waitcnt vmcnt(0)" ::: "memory");
    __syncthreads();
    if (threadIdx.x == 0) {
        unsigned* bar = b.bar;
        __builtin_amdgcn_s_waitcnt(0);
        unsigned nloc = b.st[0], nx = b.st[1];
        if (nloc == 0u) { xcd_barrier_complete(bar, b.x, nloc, nx); b.st[0] = nloc; b.st[1] = nx; }
        const unsigned old = xb_add(&bar[XB_XSUB(b.x)], 1u);
        const unsigned gen = old / nloc;
        if (old + 1u == (gen + 1u) * nloc) {
            __builtin_amdgcn_fence(__ATOMIC_RELEASE, "agent");
            asm volatile("s_waitcnt vmcnt(0)" ::: "memory");
            const unsigned og = xb_add(&bar[XB_TOP], 1u);
            const unsigned tg = og / nx;
            if (og + 1u == (tg + 1u) * nx) xb_add(&bar[XB_TOPGEN], 1u);
            else XB_SPIN(xb_ld(&bar[XB_TOPGEN]) == tg, bar);
            __builtin_amdgcn_fence(__ATOMIC_ACQUIRE, "agent");
            xb_add(&bar[XB_XGEN(b.x)], 1u);
            asm volatile("s_waitcnt vmcnt(0)" ::: "memory");
        } else {
            XB_SPIN(xb_ld(&bar[XB_XGEN(b.x)]) == gen, bar);
            __builtin_amdgcn_fence(__ATOMIC_ACQUIRE, "agent");
            asm volatile("s_waitcnt vmcnt(0)" ::: "memory");
        }
    }
    __syncthreads();
}

struct Args { const float* in[24]; float* out; unsigned char* ws; int ph_lo, ph_hi, use_bar, pad; };
struct Frame {
    LAS unsigned char* lds; int tid, lane, wave, gw, NGW, vcu, G;
    const float* const* in; float* out; unsigned char* ws;
};

__device__ const double ROPE_REV[64] = {
    0.15915494309189535, 0.13782250260398285, 0.11934937021124886, 0.10335229661843406,
    0.08949940160889101, 0.07750328875537406, 0.06711508300522726, 0.058119267441876246,
    0.050329212104487035, 0.04358330210530733, 0.03774158471741977, 0.032682865872357,
    0.0283021958306234, 0.024508691862069852, 0.02122365276477766, 0.018378926105679667,
    0.015915494309189534, 0.013782250260398284, 0.011934937021124886, 0.010335229661843406,
    0.008949940160889102, 0.0077503288755374055, 0.006711508300522725, 0.005811926744187624,
    0.005032921210448704, 0.004358330210530733, 0.003774158471741977, 0.0032682865872356993,
    0.00283021958306234, 0.002450869186206985, 0.0021223652764777662, 0.0018378926105679667,
    0.0015915494309189536, 0.0013782250260398288, 0.0011934937021124885, 0.0010335229661843405,
    0.0008949940160889102, 0.0007750328875537405, 0.0006711508300522726, 0.0005811926744187624,
    0.0005032921210448703, 0.0004358330210530733, 0.00037741584717419774, 0.0003268286587235699,
    0.00028302195830623395, 0.00024508691862069854, 0.0002122365276477766, 0.00018378926105679666,
    0.00015915494309189535, 0.00013782250260398286, 0.00011934937021124886, 0.00010335229661843406,
    8.949940160889102e-05, 7.750328875537406e-05, 6.711508300522725e-05, 5.811926744187624e-05,
    5.0329212104487035e-05, 4.358330210530732e-05, 3.774158471741978e-05, 3.2682865872357e-05,
    2.8302195830623396e-05, 2.4508691862069852e-05, 2.122365276477766e-05, 1.8378926105679668e-05};

struct TrJob { const float* src; bf16_t* dst; const float* gn; int N, ldo; };
__device__ __forceinline__ void tr_load(const TrJob& J, int lane, f32x4 (&v)[8]) {
#pragma unroll
    for (int j = 0; j < 8; ++j) v[j] = __builtin_nontemporal_load((const f32x4*)(J.src + (size_t)((lane >> 3) + 8 * j) * J.N + 4 * (lane & 7)));
}
__device__ __forceinline__ void tr_flush(const TrJob& J, const f32x4 (&v)[8], LAS float* scr, int lane) {
#pragma unroll
    for (int j = 0; j < 8; ++j) { LAS float* d = scr + ((lane >> 3) + 8 * j) * 33 + 4 * (lane & 7); d[0] = v[j][0]; d[1] = v[j][1]; d[2] = v[j][2]; d[3] = v[j][3]; }
    LDS_WAIT(); asm volatile("" ::: "memory");
    const int c = lane & 7;
#pragma unroll
    for (int j = 0; j < 4; ++j) { const int n = (lane >> 3) + 8 * j; const LAS float* s = scr + (8 * c) * 33 + n; const float sn = J.gn ? J.gn[n] : 1.0f;
        u32x4 o; o.x = cvt_pk_bf16(s[0 * 33] * sn, s[1 * 33] * sn); o.y = cvt_pk_bf16(s[2 * 33] * sn, s[3 * 33] * sn); o.z = cvt_pk_bf16(s[4 * 33] * sn, s[5 * 33] * sn); o.w = cvt_pk_bf16(s[6 * 33] * sn, s[7 * 33] * sn);
        __builtin_nontemporal_store(o, (u32x4*)(J.dst + (size_t)n * J.ldo + 8 * c)); }
    LDS_WAIT(); asm volatile("" ::: "memory");
}
__device__ __forceinline__ TrJob tr_job(const float* W, int N, int k0, int n0, bf16_t* WT, int ldo, const float* gn = nullptr) {
    TrJob J; J.src = W + (size_t)k0 * N + n0; J.dst = WT; J.gn = gn ? gn + n0 : nullptr; J.N = N; J.ldo = ldo; return J;
}
__device__ __forceinline__ void tr_item(const float* W, int N, int k0, int n0, bf16_t* WT, int ldo, LAS float* scr, int lane, const float* gn = nullptr) {
    const TrJob J = tr_job(W, N, k0, n0, WT, ldo, gn); f32x4 v[8]; tr_load(J, lane, v); asm volatile("" ::: "memory"); tr_flush(J, v, scr, lane);
}
constexpr int I_IN = 32 * 344, I_OUT = 86 * 64, I_FFN = I_IN + I_OUT;
__device__ __forceinline__ TrJob ffn_job(Frame& F, int s, int r) {
    unsigned char* ws = F.ws;
    if (r < I_IN) { const int kb = r / 344, nb = r % 344, n0 = nb * 32;
        const float* W = F.in[(s & 1) ? 11 : 7] + (size_t)(s >> 1) * D * 2 * FF;
        const int j = n0 < FF ? n0 : n0 - FF; const int drow = (j >> 7) * 256 + (n0 < FF ? 0 : 128) + (j & 127);
        return tr_job(W, 2 * FF, kb * 64, n0, (bf16_t*)(ws + WS_WIN + (size_t)s * WIN_BYTES) + (size_t)drow * D + kb * 64, D); }
    else { const int q = r - I_IN, kb = q / 64, nb = q % 64;
        const float* W = F.in[(s & 1) ? 12 : 8] + (size_t)(s >> 1) * FF * D;
        return tr_job(W, D, kb * 64, nb * 32, (bf16_t*)(ws + WS_WOUT + (size_t)s * WOUT_BYTES) + (size_t)(nb * 32) * FF + kb * 64, FF); }
}
__device__ __forceinline__ TrJob mixw_job(Frame& F, int it);
#ifndef CONV_NT
#define CONV_NT 2
#endif
template <int KIND> __device__ __forceinline__ void conv_run(Frame& F, int blk, int lo, int hi, int sw, int nsw, int lane) {
    LAS float* scr = (LAS float*)(F.lds + F.wave * 16384);
    for (int r = lo + sw; r < hi; r += CONV_NT * nsw) {
        TrJob J[CONV_NT]; f32x4 v[CONV_NT][8];
#pragma unroll
        for (int t = 0; t < CONV_NT; ++t) if (r + t * nsw < hi) { J[t] = KIND == 0 ? ffn_job(F, blk, r + t * nsw) : mixw_job(F, r + t * nsw); tr_load(J[t], lane, v[t]); }
        asm volatile("" ::: "memory");
#pragma unroll
        for (int t = 0; t < CONV_NT; ++t) if (r + t * nsw < hi) tr_flush(J[t], v[t], scr, lane);
    }
}
__device__ __forceinline__ void conv_block_range(Frame& F, int blk, int lo, int hi, int sw, int nsw, int lane) { conv_run<0>(F, blk, lo, hi, sw, nsw, lane); }
#ifndef SPW_F
#define SPW_F 10
#endif
#ifndef SPW_C
#define SPW_C 0
#endif
#ifndef SPW_Q
#define SPW_Q 10
#endif
constexpr int imin(int a, int b) { return a < b ? a : b; }
constexpr int CAP_F = 117 * 8 * SPW_F, CAP_C = 240 * 8 * SPW_C, CAP_Q = 184 * 8 * SPW_Q;
constexpr int TAILC = 128 * 8 * 7;
constexpr int DA = imin(CAP_F, I_FFN), D3 = imin(I_FFN, DA + CAP_C), D4 = imin(I_FFN, DA + (CAP_C - (D3 - DA))), D5 = imin(I_FFN, DA + CAP_Q), D6 = imin(I_FFN, DA + (CAP_Q - (D5 - DA)));
#ifndef MIXW_IN_SLACK
#define MIXW_IN_SLACK 1
#endif
constexpr int I_POOL = 8 * 16, I_CIN = 32 * 128, I_SQ = 32 * 64, I_QKV = 32 * 576, M_E3 = I_CIN, M_E4 = M_E3 + I_SQ, M_E5 = M_E4 + I_QKV, I_MIXW = M_E5 + I_SQ;
__device__ __forceinline__ TrJob mixw_job(Frame& F, int it) {
    unsigned char* ws = F.ws;
    if (it < M_E3) { const int r = it, kb = r / 128, nb = r % 128;
        return tr_job(F.in[15], 4096, kb * 64, nb * 32, (bf16_t*)(ws + WS_WCIN) + (size_t)(nb * 32) * D + kb * 64, D); }
    else if (it < M_E4) { const int r = it - M_E3, kb = r / 64, nb = r % 64;
        return tr_job(F.in[19], D, kb * 64, nb * 32, (bf16_t*)(ws + WS_WCOUT) + (size_t)(nb * 32) * D + kb * 64, D); }
    else if (it < M_E5) { const int r = it - M_E4, kb = r / 576, nb = r % 576, n0 = nb * 32, pn = n0 >> 8, i5 = (n0 >> 5) & 7;
        const int lam = pn < 48 ? (((i5 & 3) < 2 ? 0 : 128) + (i5 >> 2) * 64 + (i5 & 1) * 32) : (n0 & 255);
        return tr_job(F.in[20], NQKV, kb * 64, n0, (bf16_t*)(ws + WS_WQKV) + (size_t)(pn * 256 + lam) * D + kb * 64, D); }
    else { const int r = it - M_E5, kb = r / 64, nb = r % 64;
        return tr_job(F.in[23], D, kb * 64, nb * 32, (bf16_t*)(ws + WS_WAO) + (size_t)(nb * 32) * D + kb * 64, D); }
}
__device__ __forceinline__ void p0_prologue(Frame& F) {
    LAS float* scr = (LAS float*)(F.lds + F.wave * 16384);
    unsigned char* ws = F.ws;
    conv_block_range(F, 0, 0, I_FFN, F.gw, F.NGW, F.lane);
#pragma unroll 1
    for (int b = 1; b < 7; ++b) { const int lo0 = b == 3 ? D3 : b == 4 ? D4 : b == 5 ? D5 : b == 6 ? D6 : DA; const int lo = imin(lo0 + TAILC, I_FFN);
        conv_block_range(F, b, lo, I_FFN, F.gw, F.NGW, F.lane); }
    for (int it = F.gw; it < 8 * I_POOL; it += F.NGW) { const int jg = it / I_POOL, r = it % I_POOL, kb = r / 16, nb = r % 16;
        const float* W = F.in[13] + (size_t)jg * 512 * 512;
        tr_item(W, 512, kb * 64, nb * 32, (bf16_t*)(ws + WS_WPOOL + (size_t)(jg >> 2) * WPOOL_BYTES) + (size_t)((jg & 3) * 512 + nb * 32) * 512 + kb * 64, 512, scr, F.lane, F.in[14] + (size_t)(jg >> 2) * D + (jg & 3) * 512); }
#if !MIXW_IN_SLACK
    conv_run<1>(F, 0, 0, I_MIXW, F.gw, F.NGW, F.lane);
#endif
    { float* cst = (float*)(ws + WS_CS);
      for (int pi = F.gw; pi < SEQ + DEC_T; pi += F.NGW) { const int pos = pi < SEQ ? pi : PAST + (pi - SEQ);
          double a = (double)pos * ROPE_REV[F.lane]; a -= rint(a); const float rv = (float)a; cst[(size_t)pi * 128 + F.lane] = __builtin_amdgcn_cosf(rv); cst[(size_t)pi * 128 + 64 + F.lane] = __builtin_amdgcn_sinf(rv); } }
    { const float* w = F.in[17]; bf16_t* o = (bf16_t*)(ws + WS_WSB);
      for (int i = F.gw * 64 + F.lane; i < 8 * 128 * 128; i += F.NGW * 64) { const int q = (i >> 7) & 127, c = i & 127; const float v = c <= q ? w[i] : 0.f; o[i] = (bf16_t)(cvt_pk_bf16(v, 0.f) & 0xffffu); } }
    { float* X = (float*)(ws + WS_X); bf16_t* XB = (bf16_t*)(ws + WS_XB); float* part = (float*)(ws + WS_PART); const float* g0 = F.in[6];
      for (int m = F.gw; m < MPAD; m += F.NGW) {
          const float* src = m < MPR ? F.in[0] + (size_t)m * D : (m < MR ? F.in[1] + (size_t)(m - MPR) * D : nullptr);
          float ss = 0.f;
#pragma unroll
          for (int j = 0; j < 8; ++j) { const int c = 4 * F.lane + 256 * j; f32x4 v = src ? *(const f32x4*)(src + c) : (f32x4){0.f, 0.f, 0.f, 0.f};
              ss += (v[0] * v[0] + v[1] * v[1]) + (v[2] * v[2] + v[3] * v[3]);
              *(f32x4*)(X + (size_t)m * D + c) = v; const f32x4 g = *(const f32x4*)(g0 + c); v = v * g;
              u32x2 w; w.x = cvt_pk_bf16(v[0], v[1]); w.y = cvt_pk_bf16(v[2], v[3]); *(u32x2*)(XB + (size_t)m * D + c) = w; }
          ss = wave_sum(ss);
          if (F.lane < 8) part[(size_t)m * 8 + F.lane] = F.lane == 0 ? ss : 0.f;
          if (m >= MPR && m < MR) { float* sp = (float*)(ws + WS_SPART) + (size_t)(m - MPR) * 128; sp[F.lane] = F.lane == 0 ? ss : 0.f; sp[64 + F.lane] = 0.f; }
      } }
}

__device__ __forceinline__ float row_rstd8(const float* part, int row) {
    const f32x4* p = (const f32x4*)(part + (size_t)row * 8); const f32x4 a = p[0] + p[1];
    return rsqrtf(((a[0] + a[1]) + (a[2] + a[3])) * (1.0f / 2048.0f) + EPS);
}
__device__ __forceinline__ float row_rstd32(const float* part, int row) {
    const f32x4* p = (const f32x4*)(part + (size_t)row * 32); f32x4 a = p[0];
#pragma unroll
    for (int i = 1; i < 8; ++i) a += p[i];
    return rsqrtf(((a[0] + a[1]) + (a[2] + a[3])) * (1.0f / 2048.0f) + EPS);
}

template <int W> __device__ __forceinline__ void pool_prompt_item(Frame& F, int lane, int b, int t0, int cb, int j, const float* gmix) {
    const float* X = (const float*)(F.ws + WS_X); const float* part = (const float*)(F.ws + WS_PART); bf16_t* P = (bf16_t*)(F.ws + WS_POOLED);
    const int col = cb * 256 + 4 * lane; const f32x4 g = *(const f32x4*)(gmix + col);
    const int tl = t0 - 15 + lane;
    float rsv = 0.f; if (lane < 47 && tl >= 0) rsv = row_rstd8(part, b * SEQ + tl);
    const int rsi = __float_as_int(rsv);
    f32x4 h[16];
#pragma unroll
    for (int k = 0; k < 16; ++k) h[k] = (f32x4){0.f, 0.f, 0.f, 0.f};
#pragma unroll 1
    for (int base = 0; base < 48; base += 16) {
        f32x4 xr[16];
#pragma unroll
        for (int k = 0; k < 16; ++k) { const int i = base + k, t = t0 - 15 + i; xr[k] = (f32x4){0.f, 0.f, 0.f, 0.f}; if (i < 47 && t >= 0) xr[k] = *(const f32x4*)(X + (size_t)(b * SEQ + t) * D + col); }
        asm volatile("" ::: "memory");
#pragma unroll
        for (int k = 0; k < 16; ++k) {
            const int i = base + k, t = t0 - 15 + i;
            if (i < 47) {
                const f32x4 hn = xr[k] * __int_as_float(__builtin_amdgcn_readlane(rsi, i)); h[k] = hn;
                if (i >= 15) {
                    f32x4 s = hn;
#pragma unroll
                    for (int q = 1; q < W; ++q) s += h[(k - q) & 15];
                    const int cnt = (t + 1) < W ? (t + 1) : W; const float inv = 1.0f / (float)cnt;
                    const f32x4 hg = hn * g, o = s * g * inv - hg; u32x2 w; w.x = cvt_pk_bf16(o[0], o[1]); w.y = cvt_pk_bf16(o[2], o[3]);
                    *(u32x2*)(P + (size_t)(b * SEQ + t) * D + col) = w;
                    if (t >= SEQ - 15) *(f32x4*)(F.out + O_PP + ((size_t)(j * NBATCH + b) * 15 + (t - (SEQ - 15))) * D + col) = hg;
                }
            }
        }
    }
}
template <int W> __device__ __forceinline__ void pool_sample_item(Frame& F, int lane, int b, int cb, int j, const float* gmix) {
    const float* X = (const float*)(F.ws + WS_X); bf16_t* P = (bf16_t*)(F.ws + WS_POOLED);
    const float* st = F.in[2] + ((size_t)(j * DEC_B + b) * 15) * D;
    const int col = cb * 256 + 4 * lane; const f32x4 g = *(const f32x4*)(gmix + col);
    f32x4 hb[19];
#pragma unroll
    for (int i = 0; i < 15; ++i) hb[i] = *(const f32x4*)(st + (size_t)i * D + col);
#pragma unroll
    for (int i = 0; i < 4; ++i) hb[15 + i] = *(const f32x4*)(X + (size_t)(MPR + b * 4 + i) * D + col);
    float rsv = 0.f;
    if (lane < 4) { const f32x4* sp = (const f32x4*)((const float*)(F.ws + WS_SPART) + (size_t)(b * 4 + lane) * 128); f32x4 a = sp[0];
#pragma unroll
        for (int i = 1; i < 32; ++i) a += sp[i];
        rsv = rsqrtf(((a[0] + a[1]) + (a[2] + a[3])) * (1.0f / 2048.0f) + EPS); }
    asm volatile("" ::: "memory");
    const int rsi = __float_as_int(rsv);
#pragma unroll
    for (int i = 0; i < 4; ++i) hb[15 + i] = hb[15 + i] * __int_as_float(__builtin_amdgcn_readlane(rsi, i)) * g;
#pragma unroll
    for (int i = 4; i < 19; ++i) *(f32x4*)(F.out + O_PS + ((size_t)(j * DEC_B + b) * 15 + (i - 4)) * D + col) = hb[i];
#pragma unroll
    for (int i = 15; i < 19; ++i) {
        f32x4 s = hb[i];
#pragma unroll
        for (int q = 1; q < W; ++q) s += hb[i - q];
        const f32x4 o = s * (1.0f / (float)W) - hb[i]; u32x2 w; w.x = cvt_pk_bf16(o[0], o[1]); w.y = cvt_pk_bf16(o[2], o[3]);
        *(u32x2*)(P + (size_t)(MPR + b * 4 + (i - 15)) * D + col) = w;
    }
}
__device__ __forceinline__ void pool_phase(Frame& F, int j, const float* gmix) {
    constexpr int NP = NBATCH * 64 * 8, NS = DEC_B * 8, NZ = (MPAD - MR);
    int lane = F.lane; asm volatile("" : "+v"(lane));
    for (int it = F.gw; it < NP + NS + NZ; it += F.NGW) {
        if (it < NP) { const int cb = it & 7, seg = (it >> 3) & 63, b = it >> 9;
            switch (cb >> 1) { case 0: pool_prompt_item<2>(F, lane, b, seg * 32, cb, j, gmix); break; case 1: pool_prompt_item<4>(F, lane, b, seg * 32, cb, j, gmix); break;
                               case 2: pool_prompt_item<8>(F, lane, b, seg * 32, cb, j, gmix); break; default: pool_prompt_item<16>(F, lane, b, seg * 32, cb, j, gmix); break; } }
        else if (it < NP + NS) { const int q = it - NP, cb = q & 7, b = q >> 3;
            switch (cb >> 1) { case 0: pool_sample_item<2>(F, lane, b, cb, j, gmix); break; case 1: pool_sample_item<4>(F, lane, b, cb, j, gmix); break;
                               case 2: pool_sample_item<8>(F, lane, b, cb, j, gmix); break; default: pool_sample_item<16>(F, lane, b, cb, j, gmix); break; } }
        else { const int row = MR + (it - NP - NS); u32x4* p = (u32x4*)((bf16_t*)(F.ws + WS_POOLED) + (size_t)row * D);
#pragma unroll
            for (int k = 0; k < 4; ++k) p[lane + 64 * k] = (u32x4){0u, 0u, 0u, 0u}; }
    }
}

__device__ __forceinline__ void chunk_mix_phase(Frame& F) {
    constexpr int VP = 264;
    LAS bf16_t* VT = (LAS bf16_t*)F.lds;
    LAS float* rsv = (LAS float*)(F.lds + 70656);
    const bf16_t* U = (const bf16_t*)(F.ws + WS_U); const bf16_t* V = (const bf16_t*)(F.ws + WS_V); bf16_t* Y = (bf16_t*)(F.ws + WS_Y);
    const float* vpart = (const float*)(F.ws + WS_VPART); const bf16_t* WSB = (const bf16_t*)(F.ws + WS_WSB);
    const float* vg = F.in[16]; const float* bs = F.in[18];
    int l = F.lane; asm volatile("" : "+v"(l)); const int w = F.wave, fr = l & 15, fq = l >> 4, tid = w * 64 + l;
    constexpr int NPI = 64 * 8, NSI = DEC_B * 8;
    for (int it = F.vcu; it < NPI + NSI; it += F.G) {
        const bool smp = it >= NPI; const int g = it & 7; const int ch = smp ? (it - NPI) >> 3 : it >> 3;
        const int R0 = smp ? MPR + ch * 4 : ch * 128; const int nrows = smp ? 4 : 128;
        __syncthreads();
        if (tid < 128) { float rv = 0.f;
            if (tid < nrows) { if (smp) { const f32x4* sp = (const f32x4*)((const float*)(F.ws + WS_SVPART) + (size_t)(ch * 4 + tid) * 128); f32x4 a = sp[0];
#pragma unroll
                    for (int i = 1; i < 32; ++i) a += sp[i];
                    rv = rsqrtf(((a[0] + a[1]) + (a[2] + a[3])) * (1.0f / 2048.0f) + EPS); }
                else rv = row_rstd32(vpart, R0 + tid); }
            rsv[tid] = rv; }
        __syncthreads();
        u32x4 raw[8];
#pragma unroll
        for (int it8 = 0; it8 < 8; ++it8) { const int q = tid + 512 * it8, c = q >> 5, k = q & 31; raw[it8] = (u32x4){0u, 0u, 0u, 0u}; if (c < nrows) raw[it8] = *(const u32x4*)(V + (size_t)(R0 + c) * D + g * 256 + 8 * k); }
        asm volatile("" ::: "memory");
#pragma unroll
        for (int it8 = 0; it8 < 8; ++it8) {
            const int q = tid + 512 * it8, c = q >> 5, k = q & 31; float v[8];
            if (c < nrows) { const u32x4 rw = raw[it8]; const float rs = rsv[c];
                const f32x4 g0 = *(const f32x4*)(vg + g * 256 + 8 * k), g1 = *(const f32x4*)(vg + g * 256 + 8 * k + 4);
                v[0] = bflo(rw.x) * rs * g0[0]; v[1] = bfhi(rw.x) * rs * g0[1]; v[2] = bflo(rw.y) * rs * g0[2]; v[3] = bfhi(rw.y) * rs * g0[3];
                v[4] = bflo(rw.z) * rs * g1[0]; v[5] = bfhi(rw.z) * rs * g1[1]; v[6] = bflo(rw.w) * rs * g1[2]; v[7] = bfhi(rw.w) * rs * g1[3];
                if (smp) { float* o = F.out + O_CV + (size_t)(ch * 4 + c) * D + g * 256 + 8 * k; *(f32x4*)o = (f32x4){v[0], v[1], v[2], v[3]}; *(f32x4*)(o + 4) = (f32x4){v[4], v[5], v[6], v[7]}; }
            } else {
#pragma unroll
                for (int e = 0; e < 8; ++e) v[e] = 0.f; }
            u32x4 pk; pk.x = cvt_pk_bf16(v[0], v[1]); pk.y = cvt_pk_bf16(v[2], v[3]); pk.z = cvt_pk_bf16(v[4], v[5]); pk.w = cvt_pk_bf16(v[6], v[7]);
            *(LAS u32x4*)(VT + c * VP + 8 * k) = pk;
        }
        __syncthreads();
        const int nqt = smp ? 1 : 8, ncs = smp ? 1 : 4;
        f32x4 acc[2][8];
#pragma unroll
        for (int a = 0; a < 2; ++a)
#pragma unroll
            for (int b = 0; b < 8; ++b) acc[a][b] = (f32x4){0.f, 0.f, 0.f, 0.f};
        for (int cs = 0; cs < ncs; ++cs) {
            bf16x8 xf[2];
#pragma unroll
            for (int dt = 0; dt < 2; ++dt) { const LAS bf16_t* vp = VT + (32 * cs + 8 * fq) * VP + 32 * w + 16 * dt + fr; u32x4 t;
                t.x = (unsigned)vp[0 * VP] | ((unsigned)vp[1 * VP] << 16); t.y = (unsigned)vp[2 * VP] | ((unsigned)vp[3 * VP] << 16);
                t.z = (unsigned)vp[4 * VP] | ((unsigned)vp[5 * VP] << 16); t.w = (unsigned)vp[6 * VP] | ((unsigned)vp[7 * VP] << 16);
                xf[dt] = __builtin_bit_cast(bf16x8, t); }
            bf16x8 yf[8];
#pragma unroll
            for (int qt = 0; qt < 8; ++qt) if (qt < nqt && 16 * qt + 15 >= 32 * cs) yf[qt] = *(const bf16x8*)(WSB + ((size_t)g * 128 + 16 * qt + fr) * 128 + 32 * cs + 8 * fq);
            asm volatile("" ::: "memory");
#pragma unroll
            for (int qt = 0; qt < 8; ++qt) {
                if (qt < nqt && 16 * qt + 15 >= 32 * cs) {
#pragma unroll
                    for (int dt = 0; dt < 2; ++dt) acc[dt][qt] = __builtin_amdgcn_mfma_f32_16x16x32_bf16(xf[dt], yf[qt], acc[dt][qt], 0, 0, 0);
                }
            }
        }
        u32x2 uu[2][8]; float bq[8];
#pragma unroll
        for (int qt = 0; qt < 8; ++qt) { const int q = 16 * qt + fr; bq[qt] = 0.f;
            if (qt < nqt && q < nrows) { bq[qt] = bs[g * 128 + q];
#pragma unroll
                for (int dt = 0; dt < 2; ++dt) uu[dt][qt] = *(const u32x2*)(U + (size_t)(R0 + q) * D + g * 256 + 32 * w + 16 * dt + 4 * fq); } }
        asm volatile("" ::: "memory");
#pragma unroll
        for (int qt = 0; qt < 8; ++qt) { const int q = 16 * qt + fr;
            if (qt < nqt && q < nrows) {
#pragma unroll
                for (int dt = 0; dt < 2; ++dt) { const size_t off = (size_t)(R0 + q) * D + g * 256 + 32 * w + 16 * dt + 4 * fq;
                    const u32x2 u2 = uu[dt][qt]; const f32x4 mx = acc[dt][qt] + bq[qt];
                    u32x2 o; o.x = cvt_pk_bf16(bflo(u2.x) * mx[0], bfhi(u2.x) * mx[1]); o.y = cvt_pk_bf16(bflo(u2.y) * mx[2], bfhi(u2.y) * mx[3]);
                    *(u32x2*)(Y + off) = o; } } }
    }
    for (int r = MR + F.gw; r < MPAD; r += F.NGW) { u32x4* p = (u32x4*)(Y + (size_t)r * D);
#pragma unroll
        for (int k = 0; k < 4; ++k) p[l + 64 * k] = (u32x4){0u, 0u, 0u, 0u}; }
}


__device__ __forceinline__ int attn_swk(int rho) { return (rho & 3) | (((rho >> 3) & 3) << 2); }
struct AttnRegs { u32x4 kc[8], vc[8]; };
__device__ __forceinline__ void attn_item_load(Frame& F, int item, int l, int w, AttnRegs& R) {
    const bf16_t* KP = (const bf16_t*)(F.ws + WS_KP); const bf16_t* VBp = (const bf16_t*)(F.ws + WS_VB);
    const int tid = w * 64 + l;
    const int g = item >> 10, rem = item & 1023, b = rem >> 8, h = (rem >> 4) & 15, sb = rem & 15;
    const int sh = 2 * g, dil = 1 << sh, spr = 16 >> sh, r = sb / spr, st = sb % spr;
    const size_t rowstride = (size_t)dil * AW;
    const bf16_t* Kb = KP + (size_t)(b * SEQ + r) * AW + (g * 16 + h) * 128;
    const bf16_t* Vb = VBp + (size_t)(b * SEQ + r) * AW + (g * 16 + h) * 128;
    const int kap0 = 128 * st - 128;
#pragma unroll
    for (int j = 0; j < 8; ++j) { const int q = tid + 512 * j, rho = q >> 4, c = q & 15, kap = kap0 + rho; R.kc[j] = (u32x4){0u, 0u, 0u, 0u};
        if (kap >= 0) R.kc[j] = *(const u32x4*)(Kb + (size_t)kap * rowstride + 8 * c); }
#pragma unroll
    for (int j = 0; j < 8; ++j) { const int idx = w * 8 + j, rho = 8 * (idx >> 1) + (l >> 3), c = 2 * (l & 7) + (idx & 1), kap = kap0 + rho; R.vc[j] = (u32x4){0u, 0u, 0u, 0u};
        if (kap >= 0) R.vc[j] = *(const u32x4*)(Vb + (size_t)kap * rowstride + 8 * c); }
}
__device__ __forceinline__ void attn_item_compute(Frame& F, int item, int nxt, int l, int w, AttnRegs& R) {
    bf16_t* OG = (bf16_t*)(F.ws + WS_OG); float* LSE = (float*)(F.ws + WS_LSE);
    LAS unsigned char* Kl = F.lds; LAS unsigned char* Vl = F.lds + 65536;
    const int fr = l & 15, fq = l >> 4, tid = w * 64 + l;
    const int g = item >> 10, rem = item & 1023, b = rem >> 8, h = (rem >> 4) & 15, sb = rem & 15;
    const int sh = 2 * g, dil = 1 << sh, spr = 16 >> sh, r = sb / spr, st = sb % spr;
    const size_t rowstride = (size_t)dil * AW;
    const int kap0 = 128 * st - 128;
    const int irow = 128 * st + 16 * w + fr;
    bf16x8 qf[4];
    { const bf16_t* Qb = (const bf16_t*)(F.ws + WS_QP) + (size_t)(b * SEQ + r) * AW + (g * 16 + h) * 128;
#pragma unroll
      for (int es = 0; es < 4; ++es) qf[es] = *(const bf16x8*)(Qb + (size_t)irow * rowstride + 32 * es + 8 * fq); }
    asm volatile("" ::: "memory");
    __syncthreads();
#pragma unroll
    for (int j = 0; j < 8; ++j) { const int q = tid + 512 * j, rho = q >> 4, c = q & 15; *(LAS u32x4*)(Kl + rho * 256 + ((c ^ attn_swk(rho)) << 4)) = R.kc[j]; }
#pragma unroll
    for (int j = 0; j < 8; ++j) { const int idx = w * 8 + j, rho = 8 * (idx >> 1) + (l >> 3), c = 2 * (l & 7) + (idx & 1);
        const unsigned wv[4] = {R.vc[j].x, R.vc[j].y, R.vc[j].z, R.vc[j].w};
#pragma unroll
        for (int e = 0; e < 8; ++e) { const int d = 8 * c + e; *(LAS bf16_t*)(Vl + d * 512 + ((((rho >> 3) ^ (d & 15) ^ (d >> 4)) << 4) + (rho & 7) * 2)) = (bf16_t)((e & 1) ? (wv[e >> 1] >> 16) : (wv[e >> 1] & 0xffffu)); } }
    __syncthreads();
    if (nxt >= 0) attn_item_load(F, nxt, l, w, R);
    asm volatile("" ::: "memory");
    float mrun = -1e30f, lrun = 0.f;
    f32x4 O[8];
#pragma unroll
    for (int dt = 0; dt < 8; ++dt) O[dt] = (f32x4){0.f, 0.f, 0.f, 0.f};
    const int lam_i = 128 + 16 * w + fr;
#pragma unroll 1
    for (int s = 0; s < 5; ++s) {
        const int lam0 = 32 * ((w >> 1) + s);
        if (kap0 + lam0 < 0) continue;
        f32x4 S[2];
#pragma unroll
        for (int p = 0; p < 2; ++p) { S[p] = (f32x4){0.f, 0.f, 0.f, 0.f}; const int rho = lam0 + 8 * (fr >> 2) + 4 * p + (fr & 3); const int swz = attn_swk(rho);
#pragma unroll
            for (int es = 0; es < 4; ++es) { const bf16x8 kf = *(const LAS bf16x8*)(Kl + rho * 256 + (((4 * es + fq) ^ swz) << 4)); S[p] = __builtin_amdgcn_mfma_f32_16x16x32_bf16(kf, qf[es], S[p], 0, 0, 0); } }
        if (s == 0 || s == 4) {
#pragma unroll
            for (int p = 0; p < 2; ++p)
#pragma unroll
                for (int e = 0; e < 4; ++e) { const int lam = lam0 + 8 * fq + 4 * p + e; if (lam > lam_i || lam < lam_i - 128) S[p][e] = -__builtin_inff(); }
        }
        float mx = fmaxf(fmaxf(fmaxf(S[0][0], S[0][1]), fmaxf(S[0][2], S[0][3])), fmaxf(fmaxf(S[1][0], S[1][1]), fmaxf(S[1][2], S[1][3])));
        mx = fmaxf(mx, __shfl_xor(mx, 16)); mx = fmaxf(mx, __shfl_xor(mx, 32));
        const float mn = fmaxf(mrun, mx), al = __builtin_amdgcn_exp2f(mrun - mn); mrun = mn;
        float pv[8], ps = 0.f;
#pragma unroll
        for (int p = 0; p < 2; ++p)
#pragma unroll
            for (int e = 0; e < 4; ++e) { pv[4 * p + e] = __builtin_amdgcn_exp2f(S[p][e] - mn); ps += pv[4 * p + e]; }
        lrun = lrun * al + ps;
        u32x4 pk; pk.x = cvt_pk_bf16(pv[0], pv[1]); pk.y = cvt_pk_bf16(pv[2], pv[3]); pk.z = cvt_pk_bf16(pv[4], pv[5]); pk.w = cvt_pk_bf16(pv[6], pv[7]);
        const bf16x8 pf = __builtin_bit_cast(bf16x8, pk);
        const int vch = (lam0 >> 3) + fq;
#pragma unroll
        for (int dt = 0; dt < 8; ++dt) { const int d = 16 * dt + fr; const bf16x8 vf = *(const LAS bf16x8*)(Vl + d * 512 + ((vch ^ (d & 15) ^ (d >> 4)) << 4));
            O[dt] = __builtin_amdgcn_mfma_f32_16x16x32_bf16(vf, pf, O[dt] * al, 0, 0, 0); }
    }
    float lt = lrun; lt += __shfl_xor(lt, 16); lt += __shfl_xor(lt, 32);
    const float inv = 1.0f / lt; const int row = b * SEQ + dil * irow + r;
    bf16_t* o = OG + ((size_t)g * MPAD + row) * D + h * 128 + 4 * fq;
#pragma unroll
    for (int dt = 0; dt < 8; ++dt) { const f32x4 v = O[dt] * inv; u32x2 w2; w2.x = cvt_pk_bf16(v[0], v[1]); w2.y = cvt_pk_bf16(v[2], v[3]); *(u32x2*)(o + 16 * dt) = w2; }
    if (fq == 0) LSE[((size_t)g * MPAD + row) * 16 + h] = (mrun + __log2f(lt)) * LN2;
}
__device__ __forceinline__ void attn_sample_item(Frame& F, int item) {
    const bf16_t* QP = (const bf16_t*)(F.ws + WS_QP); bf16_t* OG = (bf16_t*)(F.ws + WS_OG); float* LSE = (float*)(F.ws + WS_LSE);
    int l = F.lane; asm volatile("" : "+v"(l));
    const int half = l >> 5, c = l & 31;
    const int h = item & 15, g = (item >> 4) % 3, bt = item / 48, b = bt >> 2, t = bt & 3;
    const int sh = 2 * g, dil = 1 << sh, L = 128 << sh;
    const float* cache = F.in[3 + g] + (size_t)b * L * 4096 + h * 128 + 4 * c;
    const float* fresh = F.out + (g == 0 ? O_K0S : (g == 1 ? O_K1S : O_K2S)) + (size_t)(b * 4) * 4096 + h * 128 + 4 * c;
    const int row = MPR + b * 4 + t;
    f32x4 q; { const u32x2 w = *(const u32x2*)(QP + (size_t)row * AW + (g * 16 + h) * 128 + 4 * c); q = (f32x4){bflo(w.x), bfhi(w.x), bflo(w.y), bfhi(w.y)}; }
    float s0 = -__builtin_inff(), s1 = s0, s2 = s0;
    const float* kp64 = cache + (size_t)(half == 0 ? t : 0) * 4096;
#pragma unroll 1
    for (int jb = 0; jb < 2; ++jb) {
        f32x4 kv[32];
#pragma unroll
        for (int u = 0; u < 32; ++u) { const int j = 2 * (32 * jb + u) + half; const int idx = L + t - dil * j;
            kv[u] = *(const f32x4*)(idx >= L ? fresh + (size_t)(idx - L) * 4096 : cache + (size_t)idx * 4096); }
        const f32x4 k64 = *(const f32x4*)kp64;
        asm volatile("" ::: "memory");
#pragma unroll
        for (int u = 0; u < 32; ++u) {
            float s = (q[0] * kv[u][0] + q[1] * kv[u][1]) + (q[2] * kv[u][2] + q[3] * kv[u][3]);
            s += __shfl_xor(s, 1); s += __shfl_xor(s, 2); s += __shfl_xor(s, 4); s += __shfl_xor(s, 8); s += __shfl_xor(s, 16);
            const bool mine = c == u;
            if (jb == 0) s0 = mine ? s : s0; else s1 = mine ? s : s1; }
        if (jb == 1) { float s = (q[0] * k64[0] + q[1] * k64[1]) + (q[2] * k64[2] + q[3] * k64[3]);
            s += __shfl_xor(s, 1); s += __shfl_xor(s, 2); s += __shfl_xor(s, 4); s += __shfl_xor(s, 8); s += __shfl_xor(s, 16);
            if (c == 0 && half == 0) s2 = s; }
    }
    float mx = fmaxf(s0, fmaxf(s1, s2));
#pragma unroll
    for (int o = 1; o < 64; o <<= 1) mx = fmaxf(mx, __shfl_xor(mx, o));
    const float p0 = __builtin_amdgcn_exp2f(s0 - mx), p1 = __builtin_amdgcn_exp2f(s1 - mx), p2 = __builtin_amdgcn_exp2f(s2 - mx);
    const float ls = wave_sum(p0 + p1 + p2);
    f32x4 o = (f32x4){0.f, 0.f, 0.f, 0.f};
#pragma unroll 1
    for (int jb = 0; jb < 2; ++jb) {
        f32x4 vv[32];
#pragma unroll
        for (int u = 0; u < 32; ++u) { const int j = 2 * (32 * jb + u) + half; const int idx = L + t - dil * j;
            vv[u] = *(const f32x4*)((idx >= L ? fresh + (size_t)(idx - L) * 4096 : cache + (size_t)idx * 4096) + 2048); }
        const f32x4 v64 = *(const f32x4*)(kp64 + 2048);
        asm volatile("" ::: "memory");
        const float psel = jb == 0 ? p0 : p1;
#pragma unroll
        for (int u = 0; u < 32; ++u) { const float pj = __shfl(psel, (l & 32) | u); o += vv[u] * pj; }
        if (jb == 1) { const float pj = __shfl(p2, l & 32); o += v64 * pj; }
    }
#pragma unroll
    for (int k = 0; k < 4; ++k) o[k] += __shfl_xor(o[k], 32);
    const float inv = 1.0f / ls;
    if (half == 0) { u32x2 w; w.x = cvt_pk_bf16(o[0] * inv, o[1] * inv); w.y = cvt_pk_bf16(o[2] * inv, o[3] * inv); *(u32x2*)(OG + ((size_t)g * MPAD + row) * D + h * 128 + 4 * c) = w;
        if (c == 0) LSE[((size_t)g * MPAD + row) * 16 + h] = (mx + __log2f(ls)) * LN2; }
}
__device__ __forceinline__ void attn_phase(Frame& F) {
    constexpr int NPI = 3 * 1024, NSI = DEC_B * DEC_T * 3 * 16;
    int l = F.lane; asm volatile("" : "+v"(l));
#ifndef SKIP_ATTN_P
#ifndef REP_AP
#define REP_AP 1
#endif
#ifndef REP_AS
#define REP_AS 1
#endif
    for (int rp = 0; rp < REP_AP; ++rp) {
        AttnRegs Ra;
        static_assert(NPI == 12 * 256, "attention prompt items");
        const int pr = F.vcu >> 1, sg = pr % 3;
        const int ne = F.vcu >= 192 ? 4 : (sg == 2 ? 0 : 2);
        const int xb = F.vcu >= 192 ? 2816 + (F.vcu - 192) * 4 : 2560 + (((pr / 3) * 2 + sg) * 2 + (F.vcu & 1)) * 2;
        const int n = F.G == 256 ? 10 + ne : 0;
#define ATT_ITEM(k) ((k) < 10 ? F.vcu + 256 * (k) : xb + ((k) - 10))
        if (F.G == 256) {
            attn_item_load(F, ATT_ITEM(0), l, F.wave, Ra);
            asm volatile("" ::: "memory");
#pragma unroll 1
            for (int k = 0; k < n; ++k) attn_item_compute(F, ATT_ITEM(k), k + 1 < n ? ATT_ITEM(k + 1) : -1, l, F.wave, Ra);
        }
#undef ATT_ITEM
    }
    __syncthreads();
#endif
    const int wg = F.vcu * 8 + F.wave;
#ifndef SKIP_ATTN_S
    for (int rp = 0; rp < REP_AS; ++rp)
    for (int it = wg; it < NSI; it += F.NGW) attn_sample_item(F, it);
#endif
}
__device__ __forceinline__ void attn_combine_phase(Frame& F) {
    const bf16_t* OG = (const bf16_t*)(F.ws + WS_OG); const float* LSE = (const float*)(F.ws + WS_LSE); bf16_t* OC = (bf16_t*)(F.ws + WS_OC);
    int l = F.lane; asm volatile("" : "+v"(l)); const int h = l >> 2;
    for (int r = F.gw; r < MPAD; r += F.NGW) {
        u32x4* dst = (u32x4*)(OC + (size_t)r * D + 32 * l);
        if (r >= MR) {
#pragma unroll
            for (int k = 0; k < 4; ++k) dst[k] = (u32x4){0u, 0u, 0u, 0u}; continue; }
        const float l0 = LSE[((size_t)0 * MPAD + r) * 16 + h], l1 = LSE[((size_t)1 * MPAD + r) * 16 + h], l2 = LSE[((size_t)2 * MPAD + r) * 16 + h];
        const float mx = fmaxf(l0, fmaxf(l1, l2)); float w0 = __expf(l0 - mx), w1 = __expf(l1 - mx), w2 = __expf(l2 - mx); const float inv = 1.0f / (w0 + w1 + w2); w0 *= inv; w1 *= inv; w2 *= inv;
        const u32x4* s0 = (const u32x4*)(OG + ((size_t)0 * MPAD + r) * D + 32 * l); const u32x4* s1 = (const u32x4*)(OG + ((size_t)1 * MPAD + r) * D + 32 * l); const u32x4* s2 = (const u32x4*)(OG + ((size_t)2 * MPAD + r) * D + 32 * l);
        u32x4 va[4], vb[4], vc[4];
#pragma unroll
        for (int k = 0; k < 4; ++k) { va[k] = s0[k]; vb[k] = s1[k]; vc[k] = s2[k]; }
        asm volatile("" ::: "memory");
#pragma unroll
        for (int k = 0; k < 4; ++k) { const u32x4 a = va[k], bq = vb[k], c = vc[k]; u32x4 o;
            o.x = cvt_pk_bf16(bflo(a.x) * w0 + bflo(bq.x) * w1 + bflo(c.x) * w2, bfhi(a.x) * w0 + bfhi(bq.x) * w1 + bfhi(c.x) * w2);
            o.y = cvt_pk_bf16(bflo(a.y) * w0 + bflo(bq.y) * w1 + bflo(c.y) * w2, bfhi(a.y) * w0 + bfhi(bq.y) * w1 + bfhi(c.y) * w2);
            o.z = cvt_pk_bf16(bflo(a.z) * w0 + bflo(bq.z) * w1 + bflo(c.z) * w2, bfhi(a.z) * w0 + bfhi(bq.z) * w1 + bfhi(c.z) * w2);
            o.w = cvt_pk_bf16(bflo(a.w) * w0 + bflo(bq.w) * w1 + bflo(c.w) * w2, bfhi(a.w) * w0 + bfhi(bq.w) * w1 + bfhi(c.w) * w2);
            dst[k] = o; }
    }
}

#ifndef NS_LOOP
#define NS_LOOP 8
#endif
#ifndef REP_P0
#define REP_P0 1
#endif
#ifndef REP_THIN
#define REP_THIN 1
#endif
#ifndef REP_POST
#define REP_POST REP_THIN
#endif
#ifndef REP_ATTN
#define REP_ATTN REP_THIN
#endif
#ifndef REP_COMB
#define REP_COMB REP_THIN
#endif
#ifndef REP_POOL
#define REP_POOL REP_THIN
#endif
#ifndef REP_MIX
#define REP_MIX REP_THIN
#endif
#ifndef REP_FFNIN
#define REP_FFNIN 1
#endif
#ifndef REP_QKV
#define REP_QKV 1
#endif
#ifndef REP_CIN
#define REP_CIN 1
#endif
#ifndef REP_FFNOUT
#define REP_FFNOUT 1
#endif
constexpr int N_PHASES = 28;
constexpr int NMP = MPAD / 256;
__global__ void __launch_bounds__(512, 2) mk_fwd(Args args) {
    extern __shared__ __attribute__((aligned(16))) unsigned char lds_raw[];
    Frame F;
    F.lds = (LAS unsigned char*)lds_raw;
    F.tid = threadIdx.x; F.lane = F.tid & 63; F.wave = __builtin_amdgcn_readfirstlane(F.tid >> 6);
    F.G = gridDim.x; { const int bx = blockIdx.x; F.vcu = (F.G % 8 == 0) ? (bx % 8) * (F.G / 8) + bx / 8 : bx; }
    F.gw = F.vcu * 8 + F.wave; F.NGW = F.G * 8;
    F.in = args.in; F.out = args.out; F.ws = args.ws;
    unsigned char* ws = args.ws;
    volatile LAS unsigned* MISC = (volatile LAS unsigned*)(F.lds + MISC_OFF);
    LAS float* tab = (LAS float*)(F.lds + TAB_OFF);
    LAS float* red = (LAS float*)(F.lds + RED_OFF);
    LAS float* stab = (LAS float*)(F.lds + STAB_OFF);
    const float* spart = (const float*)(ws + WS_SPART);
    for (int u = F.tid; u < (LDS_BYTES - TAB_OFF) / 4; u += 512) ((LAS unsigned*)(F.lds + TAB_OFF))[u] = 0u;
    __syncthreads();
    XcdBarrier bar; bar.bar = (unsigned*)(ws + WS_CTL) + CW_BAR; bar.x = 0; bar.st = nullptr;
    if (args.use_bar) bar = xcd_barrier_post((unsigned*)(ws + WS_CTL) + CW_BAR, MISC + 8);
    const int lo = args.ph_lo, hi = args.ph_hi;
    int ph = 0;
#define OPAQUE_BID() ({ int _c = (int)blockIdx.x; asm volatile("" : "+s"(_c)); _c; })
#define IN_PH() (lo <= ph && ph < hi)
#define SEAM() do { if (IN_PH() && ph + 1 < hi) { if (args.use_bar) xcd_barrier(bar); } ++ph; } while (0)

#ifndef SKIP_P0
    if (IN_PH()) for (int rep = 0; rep < REP_P0; ++rep) p0_prologue(F);
#endif
    SEAM();

#pragma unroll 1
    for (int s = 0; s < NS_LOOP; ++s) {
        const int layer = s >> 1;
        if (IN_PH()) {
#ifndef SKIP_G1
            pg8::Gemm g{(const bf16_t*)(ws + WS_XB), (const bf16_t*)(ws + WS_WIN + (size_t)s * WIN_BYTES)};
            sample_stats(spart, stab, F.tid);
            pg8::StaticOrder S; S.init(NMP, 43, F.G, OPAQUE_BID(), REP_FFNIN);
            pg8::EpiSwiglu E{(bf16_t*)(ws + WS_H), (const float*)(ws + WS_PART), tab, stab};
            pg8::gemm_phase<pg8::EpiSwiglu, D, D, D, 0, PG8_ALIGN, PG8_SP2>(F.lds, g, S, E);
            if (S.c >= 139 && s < 7) {
                int ln = F.lane; asm volatile("" : "+v"(ln)); conv_block_range(F, s + 1, 0, DA, (S.c - 139) * 8 + F.wave, 117 * 8, ln);
#if MIXW_IN_SLACK
                if (s < 5) { const int lo = s == 0 ? 0 : M_E4 + (s - 1) * (I_QKV / 3), hi = s == 0 ? M_E4 : (s == 4 ? I_MIXW : M_E4 + s * (I_QKV / 3));
                    conv_run<1>(F, 0, lo, hi, (S.c - 139) * 8 + F.wave, 117 * 8, ln); }
#endif
                }
#endif
        }
        SEAM();
        if (IN_PH()) {
#ifndef SKIP_G2
            pg8::Gemm g{(const bf16_t*)(ws + WS_H), (const bf16_t*)(ws + WS_WOUT + (size_t)s * WOUT_BYTES)};
            pg8::StaticOrder S; S.init(MPR / 256, 8, F.G, OPAQUE_BID(), REP_FFNOUT);
            const float* gnext = (s & 1) ? (s < 7 ? F.in[6] + (size_t)(layer + 1) * D : nullptr) : F.in[9] + (size_t)layer * D;
            pg8::EpiResT<REP_FFNOUT == 1> E{(float*)(ws + WS_X), (bf16_t*)(ws + WS_XB), (float*)(ws + WS_PART), s == 7 ? F.out : nullptr, nullptr, gnext, red, 0.5f, REP_FFNOUT == 2 ? 1 : 0};
            pg8::gemm_phase<pg8::EpiResT<REP_FFNOUT == 1>, FF, FF, FF, 0, true, PG8_SP2>(F.lds, g, S, E);
            { int ln = F.lane; asm volatile("" : "+v"(ln));
              skinny_out<FF, FF, FF, 0>(F.lds, F.vcu, F.wave, ln, g.A, g.Bt, E.X, E.XB, E.OUT, nullptr, gnext, 0.5f, (float*)(ws + WS_SPART));
              if (F.vcu >= 128 && s < 7) { const int b = s + 1, lo0 = b == 3 ? D3 : b == 4 ? D4 : b == 5 ? D5 : b == 6 ? D6 : DA;
                  conv_block_range(F, b, lo0, imin(lo0 + TAILC, I_FFN), (F.vcu - 128) * 8 + F.wave, 128 * 8, ln); } }
#endif
        }
        SEAM();
        if (s & 1) continue;
        const int kind = layer % 3;
        if (kind == 0) {
            const int j = layer / 3;
#ifndef SKIP_POOL
            if (IN_PH()) for (int rep = 0; rep < REP_POOL; ++rep) pool_phase(F, j, F.in[9] + (size_t)layer * D);
#endif
            SEAM();
            if (IN_PH()) {
#ifndef SKIP_G5
                pg8::Gemm g{(const bf16_t*)(ws + WS_POOLED), (const bf16_t*)(ws + WS_WPOOL + (size_t)j * WPOOL_BYTES)};
                pg8::StaticOrder S; S.init(MPR / 256, 8, F.G, OPAQUE_BID());
                pg8::EpiResT<true> E{(float*)(ws + WS_X), (bf16_t*)(ws + WS_XB), (float*)(ws + WS_PART), nullptr, nullptr, F.in[10] + (size_t)layer * D, red, 1.0f};
                pg8::gemm_phase<pg8::EpiResT<true>, D, 512, 512, 512, true, PG8_SP2>(F.lds, g, S, E);
                { int ln = F.lane; asm volatile("" : "+v"(ln));
                  skinny_out<D, 512, 512, 512>(F.lds, F.vcu, F.wave, ln, g.A, g.Bt, E.X, E.XB, nullptr, nullptr, E.gnext, 1.0f, (float*)(ws + WS_SPART)); }
#endif
            }
            SEAM();
            continue;
        }
        if (kind == 1) {
            if (IN_PH()) {
#ifndef SKIP_G3
                pg8::Gemm g{(const bf16_t*)(ws + WS_XB), (const bf16_t*)(ws + WS_WCIN)};
                sample_stats(spart, stab, F.tid);
                pg8::StaticOrder S; S.init(MPR / 256, 16, F.G, OPAQUE_BID(), REP_CIN);
                pg8::EpiGelu E{(bf16_t*)(ws + WS_U), (bf16_t*)(ws + WS_V), (float*)(ws + WS_VPART), (const float*)(ws + WS_PART), tab, stab};
                pg8::gemm_phase<pg8::EpiGelu, D, D, D, 0, PG8_ALIGN, PG8_SP2>(F.lds, g, S, E);
                { int ln = F.lane; asm volatile("" : "+v"(ln)); skinny_cin(F.lds, F.vcu, F.wave, ln, g.A, g.Bt, E.U, E.V, (float*)(ws + WS_SVPART), stab); }
#endif
            }
            SEAM();
#ifndef SKIP_MIX
            if (IN_PH()) for (int rep = 0; rep < REP_MIX; ++rep) chunk_mix_phase(F);
#endif
            SEAM();
        } else {
            if (IN_PH()) {
#ifndef SKIP_G4
                pg8::Gemm g{(const bf16_t*)(ws + WS_XB), (const bf16_t*)(ws + WS_WQKV)};
                sample_stats(spart, stab, F.tid);
                pg8::StaticOrder S; S.init(NMP, 72, F.G, OPAQUE_BID(), REP_QKV);
                pg8::EpiQKV E{(bf16_t*)(ws + WS_QP), (bf16_t*)(ws + WS_KP), (bf16_t*)(ws + WS_VB), F.out, (const float*)(ws + WS_CS), F.in[21], F.in[22], (const float*)(ws + WS_PART), tab, stab, red};
                pg8::gemm_phase<pg8::EpiQKV, D, D, D, 0, true, PG8_SP2>(F.lds, g, S, E);
                if (S.c >= 72) { int ln = F.lane; asm volatile("" : "+v"(ln)); _Pragma("unroll 1") for (int b = 5; b < 8; ++b) conv_block_range(F, b, b == 7 ? imin(DA + TAILC, I_FFN) : DA, b == 5 ? D5 : b == 6 ? D6 : I_FFN, (S.c - 72) * 8 + F.wave, 184 * 8, ln); }
#endif
            }
            SEAM();
#ifndef SKIP_ATTN
            if (IN_PH()) for (int rep = 0; rep < REP_ATTN; ++rep) attn_phase(F);
#endif
            SEAM();
#ifndef SKIP_COMB
            if (IN_PH()) for (int rep = 0; rep < REP_COMB; ++rep) attn_combine_phase(F);
#endif
            SEAM();
        }
        if (IN_PH()) {
#ifndef SKIP_G6
            pg8::Gemm g{(const bf16_t*)(ws + (kind == 1 ? WS_Y : WS_OC)), (const bf16_t*)(ws + (kind == 1 ? WS_WCOUT : WS_WAO))};
            pg8::StaticOrder S; S.init(MPR / 256, 8, F.G, OPAQUE_BID());
            pg8::EpiResT<true> E{(float*)(ws + WS_X), (bf16_t*)(ws + WS_XB), (float*)(ws + WS_PART), nullptr, nullptr, F.in[10] + (size_t)layer * D, red, 1.0f};
            pg8::gemm_phase<pg8::EpiResT<true>, D, D, D, 0, true, PG8_SP2>(F.lds, g, S, E);
            { int ln = F.lane; asm volatile("" : "+v"(ln));
              skinny_out<D, D, D, 0>(F.lds, F.vcu, F.wave, ln, g.A, g.Bt, E.X, E.XB, nullptr, nullptr, E.gnext, 1.0f, (float*)(ws + WS_SPART)); }
#endif
        }
        SEAM();
    }
#undef IN_PH
#undef SEAM
}

extern "C" void kernel_launch(void* const* d_in, const int* in_sizes, int n_in, void* d_out, int out_size, void* d_ws, size_t ws_size, hipStream_t stream) {
    static int grid = 0;
    if (grid == 0) {
        if (n_in != 24 || (size_t)out_size != O_END || ws_size < WS_END) { fprintf(stderr, "kernel_launch: unexpected shapes: n_in %d out %d ws %zu (need %zu)\n", n_in, out_size, ws_size, (size_t)WS_END); grid = -1; return; }
        int dev = 0, cus = 0, per_cu = 0;
        if (hipGetDevice(&dev) != hipSuccess || hipDeviceGetAttribute(&cus, hipDeviceAttributeMultiprocessorCount, dev) != hipSuccess) { grid = -1; return; }
        if (hipFuncSetAttribute((const void*)mk_fwd, hipFuncAttributeMaxDynamicSharedMemorySize, LDS_BYTES) != hipSuccess) { fprintf(stderr, "kernel_launch: hipFuncSetAttribute failed\n"); grid = -1; return; }
        if (hipOccupancyMaxActiveBlocksPerMultiprocessor(&per_cu, (const void*)mk_fwd, 512, LDS_BYTES) != hipSuccess || per_cu < 1) fprintf(stderr, "kernel_launch: occupancy query says %d\n", per_cu);
        (void)hipGetLastError();
        grid = cus;
    }
    if (grid < 0) return;
    (void)hipMemsetAsync((char*)d_ws + WS_CTL, 0, CTL_ZERO_BYTES, stream);
    Args a{};
    for (int i = 0; i < 24; ++i) a.in[i] = (const float*)d_in[i];
    a.out = (float*)d_out; a.ws = (unsigned char*)d_ws;
#if MK_N_LAUNCHES == 1
    a.ph_lo = 0; a.ph_hi = N_PHASES; a.use_bar = 1; a.pad = 0;
    hipLaunchKernelGGL(mk_fwd, dim3(grid), dim3(512), LDS_BYTES, stream, a);
#else
    for (int p = 0; p < N_PHASES; ++p) { a.ph_lo = p; a.ph_hi = p + 1; a.use_bar = 0; a.pad = 0; hipLaunchKernelGGL(mk_fwd, dim3(grid), dim3(512), LDS_BYTES, stream, a); }
#endif
}
```

```cpp
#include <hip/hip_runtime.h>
#include <cstdio>
#include <cstdint>

#ifndef MK_N_LAUNCHES
#define MK_N_LAUNCHES 1
#endif

#define GAS __attribute__((address_space(1)))
#define LAS __attribute__((address_space(3)))
typedef unsigned short bf16_t;
typedef short bf16x8 __attribute__((ext_vector_type(8)));
typedef float f32x4 __attribute__((ext_vector_type(4)));
typedef float f32x2 __attribute__((ext_vector_type(2)));
typedef unsigned u32x4 __attribute__((ext_vector_type(4)));
typedef unsigned u32x2 __attribute__((ext_vector_type(2)));

constexpr int D = 2048, FF = 5504, SEQ = 2048, NBATCH = 4, MPR = 8192, MS = 32, MR = 8224, MPAD = 8448;
constexpr int NQKV = 18432, HD = 128, NH = 16, AW = 6144;
constexpr int DEC_B = 8, DEC_T = 4, PAST = 16384;
constexpr float EPS = 1e-6f;
constexpr float QSCALE = 0.08838834764831845f * 1.4426950408889634f;
constexpr float LN2 = 0.6931471805599453f;

constexpr size_t O_YP = 0, O_YS = 16777216, O_PP = 16842752, O_PS = 17088512, O_CV = 17580032, O_K0P = 17645568, O_K0S = 19742720,
                 O_K1P = 19873792, O_K1S = 28262400, O_K2P = 28393472, O_K2S = 61947904, O_END = 62078976;

constexpr size_t MiB = 1u << 20;
constexpr size_t WS_CTL = 0, CTL_ZERO_BYTES = 32 * 1024;
constexpr size_t WS_PART = 1 * MiB, WS_CS = 1 * MiB + 512 * 1024  , WS_VPART = 3 * MiB, WS_LSE = 5 * MiB, WS_WSB = 7 * MiB, WS_SPART = 7 * MiB + 512 * 1024, WS_SVPART = WS_SPART + 16384;
constexpr size_t WS_WIN = 8 * MiB, WIN_BYTES = 43 * MiB;
constexpr size_t WS_WOUT = 352 * MiB, WOUT_BYTES = (size_t)2048 * 5504 * 2;
constexpr size_t WS_WPOOL = 524 * MiB, WPOOL_BYTES = 2 * MiB;
constexpr size_t WS_WCIN = 528 * MiB, WS_WCOUT = 544 * MiB, WS_WQKV = 552 * MiB, WS_WAO = 624 * MiB;
constexpr size_t WS_X = 632 * MiB, WS_XB = 698 * MiB, WS_SCR = 731 * MiB;
constexpr size_t WS_H = WS_SCR, WS_POOLED = WS_SCR, WS_U = WS_SCR, WS_V = WS_SCR + 33 * MiB, WS_Y = WS_SCR + 66 * MiB;
constexpr size_t WS_RAW = WS_SCR, WS_QP = WS_SCR + 297 * MiB, WS_KP = WS_SCR + 396 * MiB, WS_VT = WS_SCR + 495 * MiB, WS_VB = WS_VT  , WS_OG = WS_SCR, WS_OC = WS_SCR + 99 * MiB;
constexpr size_t WS_END = WS_SCR + 594 * MiB;
static_assert(WS_WOUT + 8 * WOUT_BYTES <= WS_WPOOL && WS_WIN + 8 * WIN_BYTES <= WS_WOUT, "ws map");
constexpr int CW_BAR = 4096;
static_assert((CW_BAR + 3456) * 4 <= (int)CTL_ZERO_BYTES, "barrier words inside the per-call memset");

constexpr int RING_BYTES = 131072, TAB_OFF = RING_BYTES, RED_OFF = TAB_OFF + 16384, MISC_OFF = RED_OFF + 4096, STAB_OFF = MISC_OFF + 128, LDS_BYTES = 155648;

#define LDS_WAIT() asm volatile("s_waitcnt lgkmcnt(0)" ::: "memory")
#define VM_WAIT() asm volatile("s_waitcnt vmcnt(0)" ::: "memory")
__device__ __forceinline__ unsigned cvt_pk_bf16(float lo, float hi) { unsigned r; asm volatile("v_cvt_pk_bf16_f32 %0, %1, %2" : "=v"(r) : "v"(lo), "v"(hi)); return r; }
__device__ __forceinline__ float bflo(unsigned w) { return __uint_as_float(w << 16); }
__device__ __forceinline__ float bfhi(unsigned w) { return __uint_as_float(w & 0xffff0000u); }
__device__ __forceinline__ float bf1(bf16_t b) { return __uint_as_float(((unsigned)b) << 16); }
__device__ __forceinline__ float wave_sum(float v) {
#pragma unroll
    for (int o = 1; o < 64; o <<= 1) v += __shfl_xor(v, o);
    return v;
}

namespace pg8 {
constexpr int BM = 256, BK = 64, HALF = 128, HTB = HALF * BK * 2, STAGE_BYTES = 8 * HTB, NXCD = 8, WGM = 4;
__host__ __device__ __forceinline__ int lds_byte(int r, int c) { const int st = (r >> 4) * 2 + (c >> 5), rr = r & 15, cc = c & 31, ob = rr * 64 + cc * 2; return st * 1024 + (ob ^ (((ob >> 9) & 1) << 5)); }
__host__ __device__ __forceinline__ void stage_rc(int b, int& R, int& C) { const int st = b / 1024, sb = b % 1024, swz = sb ^ (((sb >> 9) & 1) << 5); R = (st >> 1) * 16 + swz / 64; C = (st & 1) * 32 + (swz % 64) / 2; }
__host__ __device__ __forceinline__ int perm32(int rho) { const int n = rho >> 4, i = rho & 15; return 8 * (i >> 2) + 4 * n + (i & 3); }

struct Unit { int pm, pn; };
struct Gemm { const bf16_t* A; const bf16_t* Bt; };

struct StaticOrder {
    int nM, nN, nwg, G, c, rep;
    __device__ void init(int nM_, int nN_, int G_, int c_, int rep_ = 1) { nM = nM_; nN = nN_; nwg = nM * nN; G = G_; c = c_; rep = rep_; }
    __device__ bool next(int i, Unit& u) const {
        const long L = (long)(i / rep) * G + c; if (L >= nwg) return false;
        int wgid = (int)L; { const int q = nwg / NXCD, r = nwg % NXCD, xcd = wgid % NXCD, off = wgid / NXCD; wgid = (xcd < r ? xcd * (q + 1) : r * (q + 1) + (xcd - r) * q) + off; }
        const int nig = WGM * nN, gid = wgid / nig, fm = gid * WGM, gsz = (nM - fm) < WGM ? (nM - fm) : WGM;
        u.pm = fm + ((wgid % nig) % gsz); u.pn = (wgid % nig) / gsz; return true;
    }
};

typedef float f32x2v __attribute__((ext_vector_type(2)));
__device__ __forceinline__ f32x2v gelu_pk(f32x2v v) {
    const f32x2v av = __builtin_elementwise_abs(v), d = av * 0.2316418882f + 1.0f;
    f32x2v t; t.x = __builtin_amdgcn_rcpf(d.x); t.y = __builtin_amdgcn_rcpf(d.y);
    f32x2v q = t * 0.5307027145f + (-0.7265760135f); q = q * t + 0.7107068705f; q = q * t + (-0.142248368f); q = q * t + 0.127414796f; q = q * t;
    const f32x2v s = (v * v) * (-0.72134752044f);
    f32x2v e; e.x = __builtin_amdgcn_exp2f(s.x); e.y = __builtin_amdgcn_exp2f(s.y);
    const f32x2v m = v * (q * e), r = v - m;
    f32x2v o; o.x = v.x < 0.f ? m.x : r.x; o.y = v.y < 0.f ? m.y : r.y; return o;
}

__device__ __forceinline__ void rstd_prefetch(const float* part, LAS float* tab, const LAS float* stab, const Unit& u, int par) {
    int tid = threadIdx.x; asm volatile("" : "+v"(tid));
    if (u.pm == MPR / BM) { if (tid < 256) { float z = 0.f; asm volatile("" : "+v"(z));
            LAS f32x4* t4 = (LAS f32x4*)(tab + par * 2048 + tid * 8); t4[0] = (f32x4){tid < 32 ? stab[tid] : z, z, z, z}; t4[1] = (f32x4){z, z, z, z}; } }
    else __builtin_amdgcn_global_load_lds((const unsigned*)(part + (size_t)u.pm * 2048 + tid * 4), (LAS unsigned*)(tab + par * 2048 + (tid >> 6) * 256), 16, 0, 0);
}
__device__ __forceinline__ float tab_rstd(const LAS float* tab, int par, int rl) {
    const LAS f32x4* t4 = (const LAS f32x4*)(tab + par * 2048 + rl * 8); const f32x4 a = t4[0] + t4[1];
    return rsqrtf(((a[0] + a[1]) + (a[2] + a[3])) * (1.0f / 2048.0f) + EPS);
}

struct EpiSwiglu {
    static constexpr bool PERM = true, INIT_ACC = false;
    bf16_t* H; const float* part; LAS float* tab; const LAS float* stab;
    __device__ __forceinline__ void prefetch(const Unit& u, int par) const { rstd_prefetch(part, tab, stab, u, par); }
    __device__ __forceinline__ void operator()(const f32x4 (&acc)[2][2][4][2], const Unit& u, int par, int wr, int wc, int fr, int fq) const {
        const int col0 = u.pn * 128 + wc * 32 + 8 * fq;
#pragma unroll
        for (int ai = 0; ai < 2; ++ai)
#pragma unroll
            for (int m = 0; m < 4; ++m) {
                const int rl = ai * HALF + wr * 64 + m * 16 + fr; const float rs = tab_rstd(tab, par, rl);
                float o[8];
#pragma unroll
                for (int n = 0; n < 2; ++n)
#pragma unroll
                    for (int j = 0; j < 4; ++j) { const float g = acc[ai][0][m][n][j] * rs, up = acc[ai][1][m][n][j] * rs;
                        const float e = __builtin_amdgcn_exp2f(g * -1.4426950408889634f); o[n * 4 + j] = g * up * __builtin_amdgcn_rcpf(1.0f + e); }
                u32x4 w; w.x = cvt_pk_bf16(o[0], o[1]); w.y = cvt_pk_bf16(o[2], o[3]); w.z = cvt_pk_bf16(o[4], o[5]); w.w = cvt_pk_bf16(o[6], o[7]);
                *(u32x4*)(H + (size_t)(u.pm * BM + rl) * FF + col0) = w;
            }
    }
};
template <bool INIT> struct EpiResT {
    static constexpr bool PERM = true, INIT_ACC = INIT;
    float* X; bf16_t* XB; float* part; float* OUT; const float* scale; const float* gnext; LAS float* red; float factor; int probe2 = 0; const float* Xin = nullptr;
    __device__ __forceinline__ void prefetch(const Unit&, int) const {}
    __device__ __forceinline__ void init(f32x4 (&acc)[2][2][4][2], const Unit& u, int wr, int wc, int fr, int fq) const {
        const int col0 = u.pn * BM + wc * 32 + 8 * fq; const float inv = 1.0f / factor; const float* xs = Xin ? Xin : X;
#pragma unroll
        for (int ai = 0; ai < 2; ++ai)
#pragma unroll
            for (int m = 0; m < 4; ++m)
#pragma unroll
                for (int bj = 0; bj < 2; ++bj)
#pragma unroll
                    for (int n = 0; n < 2; ++n)
                        acc[ai][bj][m][n] = *(const f32x4*)(xs + (size_t)(u.pm * BM + ai * HALF + wr * 64 + m * 16 + fr) * D + col0 + bj * HALF + 4 * n) * inv;
    }
    __device__ __forceinline__ void operator()(const f32x4 (&acc)[2][2][4][2], const Unit& u, int par, int wr, int wc, int fr, int fq) const {
        const int col0 = u.pn * BM + wc * 32 + 8 * fq;
        f32x4 gn[2][2], sc[2][2];
#pragma unroll
        for (int bj = 0; bj < 2; ++bj)
#pragma unroll
            for (int n = 0; n < 2; ++n) { const int c = col0 + bj * HALF + 4 * n; gn[bj][n] = gnext ? *(const f32x4*)(gnext + c) : (f32x4){1.f, 1.f, 1.f, 1.f};
                sc[bj][n] = (scale ? *(const f32x4*)(scale + c) : (f32x4){1.f, 1.f, 1.f, 1.f}) * ((probe2 && par == 0) ? 0.f : factor); }
#pragma unroll
        for (int ai = 0; ai < 2; ++ai)
#pragma unroll
            for (int m = 0; m < 4; ++m) {
                const int rl = ai * HALF + wr * 64 + m * 16 + fr, row = u.pm * BM + rl; float ss = 0.f;
#pragma unroll
                for (int bj = 0; bj < 2; ++bj) { const size_t off = (size_t)row * D + col0 + bj * HALF;
                    const f32x4 a0 = acc[ai][bj][m][0] * sc[bj][0], a1 = acc[ai][bj][m][1] * sc[bj][1];
                    const f32x4 x0 = INIT ? a0 : *(const f32x4*)(X + off) + a0, x1 = INIT ? a1 : *(const f32x4*)(X + off + 4) + a1;
                    if (OUT) { if (row < MR) { __builtin_nontemporal_store(x0, (f32x4*)(OUT + off)); __builtin_nontemporal_store(x1, (f32x4*)(OUT + off + 4)); } continue; }
                    *(f32x4*)(X + off) = x0; *(f32x4*)(X + off + 4) = x1;
                    const f32x4 g0 = x0 * gn[bj][0], g1 = x1 * gn[bj][1];
                    u32x4 w; w.x = cvt_pk_bf16(g0[0], g0[1]); w.y = cvt_pk_bf16(g0[2], g0[3]); w.z = cvt_pk_bf16(g1[0], g1[1]); w.w = cvt_pk_bf16(g1[2], g1[3]); *(u32x4*)(XB + off) = w;
                    ss += ((x0[0] * x0[0] + x0[1] * x0[1]) + (x0[2] * x0[2] + x0[3] * x0[3])) + ((x1[0] * x1[0] + x1[1] * x1[1]) + (x1[2] * x1[2] + x1[3] * x1[3])); }
                ss += __shfl_xor(ss, 16); ss += __shfl_xor(ss, 32);
                if (fq == 0) red[rl * 4 + wc] = ss;
                asm volatile("" ::: "memory");
            }
        asm volatile("s_waitcnt lgkmcnt(0)" ::: "memory"); __builtin_amdgcn_s_barrier(); asm volatile("" ::: "memory");
        if (threadIdx.x < 256) { const f32x4 r4 = *(const LAS f32x4*)(red + threadIdx.x * 4); part[(size_t)(u.pm * BM + threadIdx.x) * 8 + u.pn] = (r4[0] + r4[1]) + (r4[2] + r4[3]); }
    }
};
typedef EpiResT<false> EpiRes;
struct EpiGelu {
    static constexpr bool PERM = true, INIT_ACC = false;
    bf16_t* U; bf16_t* V; float* vpart; const float* part; LAS float* tab; const LAS float* stab;
    __device__ __forceinline__ void prefetch(const Unit& u, int par) const { rstd_prefetch(part, tab, stab, u, par); }
    __device__ __forceinline__ void operator()(const f32x4 (&acc)[2][2][4][2], const Unit& u, int par, int wr, int wc, int fr, int fq) const {
        const bool isv = u.pn >= 8; bf16_t* O = isv ? V : U; const int col0 = (u.pn & 7) * BM + wc * 32 + 8 * fq;
#pragma unroll
        for (int ai = 0; ai < 2; ++ai)
#pragma unroll
            for (int m = 0; m < 4; ++m) {
                const int rl = ai * HALF + wr * 64 + m * 16 + fr; const float rs = tab_rstd(tab, par, rl); float ss = 0.f;
#pragma unroll
                for (int bj = 0; bj < 2; ++bj) {
                    const f32x4 v0 = acc[ai][bj][m][0] * rs, v1 = acc[ai][bj][m][1] * rs;
                    const f32x2v a = gelu_pk((f32x2v){v0[0], v0[1]}), b = gelu_pk((f32x2v){v0[2], v0[3]}), c = gelu_pk((f32x2v){v1[0], v1[1]}), d = gelu_pk((f32x2v){v1[2], v1[3]});
                    ss += (a.x * a.x + a.y * a.y) + (b.x * b.x + b.y * b.y) + (c.x * c.x + c.y * c.y) + (d.x * d.x + d.y * d.y);
                    u32x4 w; w.x = cvt_pk_bf16(a.x, a.y); w.y = cvt_pk_bf16(b.x, b.y); w.z = cvt_pk_bf16(c.x, c.y); w.w = cvt_pk_bf16(d.x, d.y);
                    *(u32x4*)(O + (size_t)(u.pm * BM + rl) * D + col0 + bj * HALF) = w; }
                if (isv) { ss += __shfl_xor(ss, 16); ss += __shfl_xor(ss, 32); if (fq == 0) vpart[(size_t)(u.pm * BM + rl) * 32 + (u.pn - 8) * 4 + wc] = ss; }
            }
    }
};
struct EpiQKV {
    static constexpr bool PERM = true, INIT_ACC = false;
    bf16_t* QP; bf16_t* KP; bf16_t* VB; float* out; const float* cs; const float* qg; const float* kg; const float* part; LAS float* tab; const LAS float* stab; LAS float* red;
    __device__ __forceinline__ void prefetch(const Unit& u, int par) const { rstd_prefetch(part, tab, stab, u, par); }
    __device__ __forceinline__ float* kv_out(int row, int g, int kv) const {
        const int keep = g == 0 ? 128 : (g == 1 ? 512 : 2048);
        if (row < MPR) { const int t = row & (SEQ - 1), b = row >> 11; if (t < SEQ - keep) return nullptr;
            return out + (g == 0 ? O_K0P : (g == 1 ? O_K1P : O_K2P)) + ((size_t)(b * keep + (t - (SEQ - keep))) * 2 + kv) * 2048; }
        if (row < MR) return out + (g == 0 ? O_K0S : (g == 1 ? O_K1S : O_K2S)) + ((size_t)(row - MPR) * 2 + kv) * 2048;
        return nullptr;
    }
    __device__ __forceinline__ void operator()(const f32x4 (&acc)[2][2][4][2], const Unit& u, int par, int wr, int wc, int fr, int fq) const {
        const int s = u.pn / 24, g = (u.pn % 24) >> 3, hp = u.pn & 7;
        if (s == 2) {
#pragma unroll
            for (int ai = 0; ai < 2; ++ai)
#pragma unroll
                for (int m = 0; m < 4; ++m) {
                    const int rl = ai * HALF + wr * 64 + m * 16 + fr, row = u.pm * BM + rl; const float rs = tab_rstd(tab, par, rl);
                    float* ov = kv_out(row, g, 1);
#pragma unroll
                    for (int bj = 0; bj < 2; ++bj) {
                        const f32x4 v0 = acc[ai][bj][m][0] * rs, v1 = acc[ai][bj][m][1] * rs; const int col = g * 2048 + (2 * hp + bj) * 128 + wc * 32 + 8 * fq;
                        u32x4 w; w.x = cvt_pk_bf16(v0[0], v0[1]); w.y = cvt_pk_bf16(v0[2], v0[3]); w.z = cvt_pk_bf16(v1[0], v1[1]); w.w = cvt_pk_bf16(v1[2], v1[3]);
                        *(u32x4*)(VB + (size_t)row * AW + col) = w;
                        if (ov) { float* o = ov + (2 * hp + bj) * 128 + wc * 32 + 8 * fq; __builtin_nontemporal_store((f32x4){bflo(w.x), bfhi(w.x), bflo(w.y), bfhi(w.y)}, (f32x4*)o); __builtin_nontemporal_store((f32x4){bflo(w.z), bfhi(w.z), bflo(w.w), bfhi(w.w)}, (f32x4*)(o + 4)); }
                    }
                }
            return;
        }
#pragma unroll
        for (int ai = 0; ai < 2; ++ai)
#pragma unroll
            for (int m = 0; m < 4; ++m) {
                const int rl = ai * HALF + wr * 64 + m * 16 + fr; const float rs = tab_rstd(tab, par, rl); float ss = 0.f;
#pragma unroll
                for (int bj = 0; bj < 2; ++bj)
#pragma unroll
                    for (int n = 0; n < 2; ++n) { const f32x4 x = acc[ai][bj][m][n] * rs; ss += (x[0] * x[0] + x[1] * x[1]) + (x[2] * x[2] + x[3] * x[3]); }
                ss += __shfl_xor(ss, 16); ss += __shfl_xor(ss, 32);
                if (fq == 0) red[rl * 4 + wc] = ss;
            }
        asm volatile("s_waitcnt lgkmcnt(0)" ::: "memory"); __builtin_amdgcn_s_barrier(); asm volatile("" ::: "memory");
        const float* gain = s == 0 ? qg : kg; const int e1 = 32 * (wc & 1) + 8 * fq, head = 2 * hp + (wc >> 1);
        const f32x4 g1a = *(const f32x4*)(gain + e1), g1b = *(const f32x4*)(gain + e1 + 4), g2a = *(const f32x4*)(gain + 64 + e1), g2b = *(const f32x4*)(gain + 64 + e1 + 4);
        const float osc = s == 0 ? QSCALE : 1.0f; bf16_t* dstb = (s == 0 ? QP : KP) + g * 2048 + head * 128 + e1;
#pragma unroll
        for (int aim = 0; aim < 4; ++aim) { const int ai = aim >> 1, m0 = (aim & 1) * 2;
            f32x4 tca[2], tcb[2], tsa[2], tsb[2];
#pragma unroll
            for (int mm = 0; mm < 2; ++mm) { const int row = u.pm * BM + ai * HALF + wr * 64 + (m0 + mm) * 16 + fr;
                const int pi = row < MPR ? (row & (SEQ - 1)) : (row < MR ? SEQ + ((row - MPR) & 3) : 0); const float* cp = cs + (size_t)pi * 128 + e1;
                tca[mm] = *(const f32x4*)cp; tcb[mm] = *(const f32x4*)(cp + 4); tsa[mm] = *(const f32x4*)(cp + 64); tsb[mm] = *(const f32x4*)(cp + 68); }
            asm volatile("" ::: "memory");
#pragma unroll
            for (int mm = 0; mm < 2; ++mm) { const int m = m0 + mm;
                const int rl = ai * HALF + wr * 64 + m * 16 + fr, row = u.pm * BM + rl; const float rs = tab_rstd(tab, par, rl);
                const float tot = red[rl * 4 + (wc & 2)] + red[rl * 4 + (wc | 1)]; const float f = rs * rsqrtf(tot * (1.0f / 128.0f) + EPS);
                const f32x4 ca = tca[mm], cb = tcb[mm], sa = tsa[mm], sb = tsb[mm];
                const f32x4 y1a = acc[ai][0][m][0] * f * g1a, y1b = acc[ai][0][m][1] * f * g1b, y2a = acc[ai][1][m][0] * f * g2a, y2b = acc[ai][1][m][1] * f * g2b;
                const f32x4 o1a = y1a * ca - y2a * sa, o1b = y1b * cb - y2b * sb, o2a = y1a * sa + y2a * ca, o2b = y1b * sb + y2b * cb;
                u32x4 w1, w2;
                w1.x = cvt_pk_bf16(o1a[0] * osc, o1a[1] * osc); w1.y = cvt_pk_bf16(o1a[2] * osc, o1a[3] * osc); w1.z = cvt_pk_bf16(o1b[0] * osc, o1b[1] * osc); w1.w = cvt_pk_bf16(o1b[2] * osc, o1b[3] * osc);
                w2.x = cvt_pk_bf16(o2a[0] * osc, o2a[1] * osc); w2.y = cvt_pk_bf16(o2a[2] * osc, o2a[3] * osc); w2.z = cvt_pk_bf16(o2b[0] * osc, o2b[1] * osc); w2.w = cvt_pk_bf16(o2b[2] * osc, o2b[3] * osc);
                *(u32x4*)(dstb + (size_t)row * AW) = w1; *(u32x4*)(dstb + (size_t)row * AW + 64) = w2;
                if (s == 1) { float* ok = kv_out(row, g, 0);
                    if (ok) { ok += head * 128 + e1; __builtin_nontemporal_store(o1a, (f32x4*)ok); __builtin_nontemporal_store(o1b, (f32x4*)(ok + 4)); __builtin_nontemporal_store(o2a, (f32x4*)(ok + 64)); __builtin_nontemporal_store(o2b, (f32x4*)(ok + 68)); } }
            }
        }
    }
};

template <class Epi, int LDA, int LDB, int KK, int AGS, bool ALIGN_EPI, bool SP2>
__device__ __forceinline__ void gemm_phase(LAS unsigned char* lds, const Gemm g, const StaticOrder& S, const Epi& E) {
    int tid = threadIdx.x; asm volatile("" : "+v"(tid));
    const int wid = __builtin_amdgcn_readfirstlane(tid >> 6), lane = tid & 63, wr = wid >> 2, wc = wid & 3, fr = lane & 15, fq = lane >> 4;
    constexpr int nt = KK / BK;
    unsigned voffA[2], voffB[2];
#pragma unroll
    for (int i = 0; i < 2; ++i) { int R, C; stage_rc(tid * 16 + i * 8192, R, C); const int Rb = Epi::PERM ? ((R & ~31) + perm32(R & 31)) : R;
        voffA[i] = (unsigned)(R * LDA + C) * 2u; voffB[i] = (unsigned)(Rb * LDB + C) * 2u; }
    constexpr size_t kstep = (size_t)(BK * 2);
    constexpr size_t hstepA = (size_t)HALF * LDA * 2, hstepB = (size_t)HALF * LDB * 2;
    constexpr size_t tstepA = 2 * hstepA, tstepB = 2 * hstepB;
    const unsigned ldsw = (unsigned)wid * 1024u;
    const int aoff = lds_byte(wr * 64 + fr, fq * 8), boff = lds_byte(wc * 32 + fr, fq * 8);
#define PG8_UA(u) ((const char*)g.A + (size_t)(u).pm * tstepA + (AGS ? (size_t)((u).pn >> 1) * (size_t)AGS * 2 : (size_t)0))
#define PG8_UB(u) ((const char*)g.Bt + (size_t)(u).pn * tstepB)
#define PG8_SA(b, h) (((b) * 2 + (h)) * HTB)
#define PG8_SB(b, h) ((4 + (b) * 2 + (h)) * HTB)
#define PG8_STAGE(bufoff, gbase, voff) do { _Pragma("unroll") for (int _i = 0; _i < 2; ++_i) \
        __builtin_amdgcn_global_load_lds((const unsigned*)((const char*)(gbase) + (voff)[_i]), (LAS unsigned*)(lds + (bufoff) + ldsw + _i * 8192), 16, 0, 0); } while (0)
#define PG8_LDA(dst, b, h) do { _Pragma("unroll") for (int m = 0; m < 4; ++m) _Pragma("unroll") for (int k = 0; k < 2; ++k) dst[m][k] = *(const LAS bf16x8*)(lds + PG8_SA(b, h) + aoff + m * 2048 + k * 1024); } while (0)
#define PG8_LDB(dst, b, h) do { _Pragma("unroll") for (int n = 0; n < 2; ++n) _Pragma("unroll") for (int k = 0; k < 2; ++k) dst[n][k] = *(const LAS bf16x8*)(lds + PG8_SB(b, h) + boff + n * 2048 + k * 1024); } while (0)
#define PG8_MMA(ai, bj, At, Bt) do { __builtin_amdgcn_s_setprio(1); _Pragma("unroll") for (int m = 0; m < 4; ++m) _Pragma("unroll") for (int n = 0; n < 2; ++n) _Pragma("unroll") for (int k = 0; k < 2; ++k) \
        acc[ai][bj][m][n] = __builtin_amdgcn_mfma_f32_16x16x32_bf16(Bt[n][k], At[m][k], acc[ai][bj][m][n], 0, 0, 0); __builtin_amdgcn_s_setprio(0); } while (0)
#define PG8_WAIT_V(n) asm volatile("s_waitcnt vmcnt(" #n ")" ::: "memory")
#define PG8_WAIT_L(n) asm volatile("s_waitcnt lgkmcnt(" #n ")" ::: "memory")
#define PG8_BAR __builtin_amdgcn_s_barrier()
#define PG8_SCHED __builtin_amdgcn_sched_barrier(0)
    Unit cur, nxt; int ui = 0;
    if (!S.next(0, cur)) return;
    f32x4 acc[2][2][4][2];
#pragma unroll
    for (int a = 0; a < 2; ++a)
#pragma unroll
        for (int b = 0; b < 2; ++b)
#pragma unroll
            for (int m = 0; m < 4; ++m)
#pragma unroll
                for (int n = 0; n < 2; ++n) acc[a][b][m][n] = (f32x4){0.f, 0.f, 0.f, 0.f};
    if constexpr (Epi::INIT_ACC) E.init(acc, cur, wr, wc, fr, fq);
    bf16x8 At[4][2], B0[2][2], B1[2][2];
    const char* cA = PG8_UA(cur); const char* cB = PG8_UB(cur);
    E.prefetch(cur, 0);
    if constexpr (SP2) {
        PG8_STAGE(PG8_SB(0, 0), cB, voffB); PG8_STAGE(PG8_SB(0, 1), cB + hstepB, voffB); PG8_STAGE(PG8_SA(0, 0), cA, voffA); PG8_STAGE(PG8_SA(0, 1), cA + hstepA, voffA);
        if (wr == 1) PG8_BAR;
        PG8_WAIT_V(2); PG8_BAR;
        PG8_STAGE(PG8_SB(1, 0), cB + kstep, voffB); PG8_STAGE(PG8_SA(1, 0), cA + kstep, voffA); PG8_STAGE(PG8_SB(1, 1), cB + hstepB + kstep, voffB);
        PG8_WAIT_V(6); PG8_BAR;
    } else {
        PG8_STAGE(PG8_SB(0, 0), cB, voffB); PG8_STAGE(PG8_SA(0, 0), cA, voffA); PG8_STAGE(PG8_SB(0, 1), cB + hstepB, voffB); PG8_STAGE(PG8_SA(0, 1), cA + hstepA, voffA);
        if (wr == 1) PG8_BAR;
        PG8_WAIT_V(4); PG8_BAR;
        PG8_STAGE(PG8_SB(1, 0), cB + kstep, voffB); PG8_STAGE(PG8_SA(1, 0), cA + kstep, voffA); PG8_STAGE(PG8_SB(1, 1), cB + hstepB + kstep, voffB);
        PG8_WAIT_V(6); PG8_BAR;
    }
    for (;;) {
        const bool has_next = S.next(ui + 1, nxt);
        const char* nA = has_next ? PG8_UA(nxt) : cA; const char* nB = has_next ? PG8_UB(nxt) : cB;
        for (int t = 0; t < nt; t += 2) {
            const bool last = (t == nt - 2);
            const char* a1 = cA + (size_t)(t + 1) * kstep;
            const char* a2 = last ? nA : cA + (size_t)(t + 2) * kstep; const char* b2 = last ? nB : cB + (size_t)(t + 2) * kstep;
            const char* a3 = a2 + kstep; const char* b3 = b2 + kstep;
            if (last && has_next) E.prefetch(nxt, (ui + 1) & 1);
            if constexpr (SP2) {
            PG8_LDB(B0, 0, 0); PG8_LDB(B1, 0, 1); PG8_SCHED; PG8_LDA(At, 0, 0); PG8_STAGE(PG8_SA(1, 1), a1 + hstepA, voffA);
            PG8_WAIT_V(8); PG8_WAIT_L(0); PG8_BAR; PG8_MMA(0, 0, At, B0); PG8_MMA(0, 1, At, B1); PG8_BAR; PG8_SCHED;
            PG8_LDA(At, 0, 1); PG8_STAGE(PG8_SB(0, 0), b2, voffB); PG8_STAGE(PG8_SB(0, 1), b2 + hstepB, voffB); PG8_STAGE(PG8_SA(0, 0), a2, voffA);
            PG8_WAIT_V(8); PG8_WAIT_L(0); PG8_BAR; PG8_MMA(1, 0, At, B0); PG8_MMA(1, 1, At, B1); PG8_BAR; PG8_SCHED;
            PG8_LDB(B0, 1, 0); PG8_LDB(B1, 1, 1); PG8_SCHED; PG8_LDA(At, 1, 0); PG8_STAGE(PG8_SA(0, 1), a2 + hstepA, voffA);
            PG8_WAIT_V(8); PG8_WAIT_L(0); PG8_BAR; PG8_MMA(0, 0, At, B0); PG8_MMA(0, 1, At, B1); PG8_BAR; PG8_SCHED;
            PG8_LDA(At, 1, 1); PG8_STAGE(PG8_SB(1, 0), b3, voffB); PG8_STAGE(PG8_SB(1, 1), b3 + hstepB, voffB); PG8_STAGE(PG8_SA(1, 0), a3, voffA);
            PG8_WAIT_V(8); PG8_WAIT_L(0); PG8_BAR; PG8_MMA(1, 0, At, B0); PG8_MMA(1, 1, At, B1); PG8_BAR; PG8_SCHED;
            } else {
            PG8_LDB(B0, 0, 0); PG8_SCHED; PG8_LDA(At, 0, 0); PG8_STAGE(PG8_SA(1, 1), a1 + hstepA, voffA);
            PG8_WAIT_L(8); PG8_BAR; PG8_WAIT_L(0); PG8_MMA(0, 0, At, B0); PG8_BAR; PG8_SCHED;
            PG8_LDB(B1, 0, 1); PG8_STAGE(PG8_SB(0, 0), b2, voffB);
            PG8_BAR; PG8_WAIT_L(0); PG8_MMA(0, 1, At, B1); PG8_BAR;
            PG8_LDA(At, 0, 1); PG8_STAGE(PG8_SA(0, 0), a2, voffA);
            PG8_BAR; PG8_WAIT_L(0); PG8_MMA(1, 0, At, B0); PG8_BAR; PG8_SCHED;
            PG8_STAGE(PG8_SB(0, 1), b2 + hstepB, voffB);
            PG8_WAIT_V(6); PG8_BAR; PG8_MMA(1, 1, At, B1); PG8_BAR;
            PG8_LDB(B0, 1, 0); PG8_SCHED; PG8_LDA(At, 1, 0); PG8_STAGE(PG8_SA(0, 1), a2 + hstepA, voffA);
            PG8_WAIT_L(8); PG8_BAR; PG8_WAIT_L(0); PG8_MMA(0, 0, At, B0); PG8_BAR; PG8_SCHED;
            PG8_LDB(B1, 1, 1); PG8_STAGE(PG8_SB(1, 0), b3, voffB);
            PG8_BAR; PG8_WAIT_L(0); PG8_MMA(0, 1, At, B1); PG8_BAR;
            PG8_LDA(At, 1, 1); PG8_STAGE(PG8_SA(1, 0), a3, voffA);
            PG8_BAR; PG8_WAIT_L(0); PG8_MMA(1, 0, At, B0); PG8_BAR; PG8_SCHED;
            PG8_STAGE(PG8_SB(1, 1), b3 + hstepB, voffB);
            PG8_WAIT_V(6); PG8_BAR; PG8_MMA(1, 1, At, B1); PG8_BAR;
            }
        }
        if constexpr (ALIGN_EPI) { if (wr == 0) PG8_BAR; }
        { int t2 = threadIdx.x; asm volatile("" : "+v"(t2));
          E(acc, cur, ui & 1, wr, wc, t2 & 15, (t2 >> 4) & 3); }
        if (!has_next) break;
#pragma unroll
        for (int a = 0; a < 2; ++a)
#pragma unroll
            for (int b = 0; b < 2; ++b)
#pragma unroll
                for (int m = 0; m < 4; ++m)
#pragma unroll
                    for (int n = 0; n < 2; ++n) acc[a][b][m][n] = (f32x4){0.f, 0.f, 0.f, 0.f};
        if constexpr (Epi::INIT_ACC) E.init(acc, nxt, wr, wc, fr, fq);
        cur = nxt; cA = nA; cB = nB; ++ui;
        if constexpr (ALIGN_EPI) { if (wr == 1) PG8_BAR; }
    }
    PG8_WAIT_V(0);
    if constexpr (!ALIGN_EPI) { if (wr == 0) PG8_BAR; }
    PG8_BAR;
#undef PG8_UA
#undef PG8_UB
#undef PG8_SA
#undef PG8_SB
#undef PG8_STAGE
#undef PG8_LDA
#undef PG8_LDB
#undef PG8_MMA
#undef PG8_WAIT_V
#undef PG8_WAIT_L
#undef PG8_BAR
#undef PG8_SCHED
}
}

#ifndef PG8_SP2
#define PG8_SP2 true
#endif
#ifndef PG8_ALIGN
#define PG8_ALIGN true
#endif

template <int LDA, int LDB, int KK, int AGS>
__device__ __forceinline__ void skinny_out(LAS unsigned char* lds, int ct, int wave, int lane, const bf16_t* A, const bf16_t* Bt, float* X, bf16_t* XB, float* OUT, const float* scale, const float* gnext, float factor, float* spart) {
    if (ct >= 128) return;
    const int fr = lane & 15, fq = lane >> 4;
    const bf16_t* Ab = A + (size_t)MPR * LDA + (AGS ? (ct >> 5) * AGS : 0) + (size_t)fr * LDA + 8 * fq;
    const bf16_t* Wb = Bt + (size_t)(16 * ct + fr) * LDB + 8 * fq;
    f32x4 acc0 = (f32x4){0.f, 0.f, 0.f, 0.f}, acc1 = acc0;
    constexpr int NK = KK / 32, PER = (NK + 7) / 8, UB = PER < 11 ? PER : 11;
#pragma unroll
    for (int b0 = 0; b0 < PER; b0 += UB) {
        bf16x8 xf[UB], y0[UB], y1[UB];
#pragma unroll
        for (int u = 0; u < UB; ++u) { const int i = b0 + u;
            if (i < PER) { const int ks = wave + 8 * i; const bool ok = (8 * i + 7 < NK) || ks < NK; const int kc = ok ? ks : 0;
                xf[u] = *(const bf16x8*)(Wb + 32 * kc); y0[u] = *(const bf16x8*)(Ab + 32 * kc); y1[u] = *(const bf16x8*)(Ab + (size_t)16 * LDA + 32 * kc);
                if (8 * i + 7 >= NK) { if (!ok) xf[u] = (bf16x8){0, 0, 0, 0, 0, 0, 0, 0}; } } }
        asm volatile("s_waitcnt vmcnt(0)" ::: "memory");
#pragma unroll
        for (int u = 0; u < UB; ++u) { if (b0 + u < PER) {
            acc0 = __builtin_amdgcn_mfma_f32_16x16x32_bf16(xf[u], y0[u], acc0, 0, 0, 0); acc1 = __builtin_amdgcn_mfma_f32_16x16x32_bf16(xf[u], y1[u], acc1, 0, 0, 0); } }
    }
    LAS f32x4* red2 = (LAS f32x4*)lds;
    red2[(wave * 2 + 0) * 64 + lane] = acc0; red2[(wave * 2 + 1) * 64 + lane] = acc1;
    __syncthreads();
    if (wave < 2) {
        f32x4 a = red2[(0 * 2 + wave) * 64 + lane];
#pragma unroll
        for (int w = 1; w < 8; ++w) a += red2[(w * 2 + wave) * 64 + lane];
        const int row = MPR + 16 * wave + fr, c = 16 * ct + 4 * fq; const size_t off = (size_t)row * D + c;
        a = a * factor; if (scale) a = a * *(const f32x4*)(scale + c);
        const f32x4 xn = *(const f32x4*)(X + off) + a;
        *(f32x4*)(X + off) = xn; if (OUT) *(f32x4*)(OUT + off) = xn;
        f32x4 xg = xn; if (gnext) xg = xg * *(const f32x4*)(gnext + c);
        u32x2 w2; w2.x = cvt_pk_bf16(xg[0], xg[1]); w2.y = cvt_pk_bf16(xg[2], xg[3]); *(u32x2*)(XB + off) = w2;
        float ss = (xn[0] * xn[0] + xn[1] * xn[1]) + (xn[2] * xn[2] + xn[3] * xn[3]);
        ss += __shfl_xor(ss, 16); ss += __shfl_xor(ss, 32);
        if (fq == 0) spart[(size_t)(16 * wave + fr) * 128 + ct] = ss;
    }
    __syncthreads();
}
__device__ __forceinline__ void skinny_cin(LAS unsigned char* lds, int ct, int wave, int lane, const bf16_t* XBp, const bf16_t* Wc, bf16_t* U, bf16_t* V, float* svpart, const LAS float* stab) {
    if (ct >= 256) return;
    const int fr = lane & 15, fq = lane >> 4;
    const bf16_t* Ab = XBp + (size_t)MPR * D + (size_t)fr * D + 8 * fq;
    const bf16_t* Wb = Wc + (size_t)(16 * ct + fr) * D + 8 * fq;
    f32x4 acc0 = (f32x4){0.f, 0.f, 0.f, 0.f}, acc1 = acc0;
    bf16x8 xf[8], y0[8], y1[8];
#pragma unroll
    for (int u = 0; u < 8; ++u) { const int ks = wave + 8 * u; xf[u] = *(const bf16x8*)(Wb + 32 * ks); y0[u] = *(const bf16x8*)(Ab + 32 * ks); y1[u] = *(const bf16x8*)(Ab + (size_t)16 * D + 32 * ks); }
    asm volatile("s_waitcnt vmcnt(0)" ::: "memory");
#pragma unroll
    for (int u = 0; u < 8; ++u) { acc0 = __builtin_amdgcn_mfma_f32_16x16x32_bf16(xf[u], y0[u], acc0, 0, 0, 0); acc1 = __builtin_amdgcn_mfma_f32_16x16x32_bf16(xf[u], y1[u], acc1, 0, 0, 0); }
    LAS f32x4* red2 = (LAS f32x4*)lds;
    red2[(wave * 2 + 0) * 64 + lane] = acc0; red2[(wave * 2 + 1) * 64 + lane] = acc1;
    __syncthreads();
    if (wave < 2) {
        f32x4 a = red2[(0 * 2 + wave) * 64 + lane];
#pragma unroll
        for (int w = 1; w < 8; ++w) a += red2[(w * 2 + wave) * 64 + lane];
        const int rl = 16 * wave + fr; const float rs = rsqrtf(stab[rl] * (1.0f / 2048.0f) + EPS);
        a = a * rs;
        const pg8::f32x2v p = pg8::gelu_pk((pg8::f32x2v){a[0], a[1]}), q = pg8::gelu_pk((pg8::f32x2v){a[2], a[3]});
        const bool isv = ct >= 128; const int c = (16 * ct + 4 * fq) & (D - 1);
        u32x2 w2; w2.x = cvt_pk_bf16(p.x, p.y); w2.y = cvt_pk_bf16(q.x, q.y);
        *(u32x2*)((isv ? V : U) + (size_t)(MPR + rl) * D + c) = w2;
        float ss = (p.x * p.x + p.y * p.y) + (q.x * q.x + q.y * q.y);
        ss += __shfl_xor(ss, 16); ss += __shfl_xor(ss, 32);
        if (isv && fq == 0) svpart[(size_t)rl * 128 + (ct - 128)] = ss;
    }
    __syncthreads();
}
__device__ __forceinline__ void sample_stats(const float* spart, LAS float* stab, int tid) {
    asm volatile("" : "+v"(tid));
    const int row = tid >> 4, sub = tid & 15; const f32x4* p = (const f32x4*)(spart + (size_t)row * 128 + sub * 8);
    const f32x4 a = p[0] + p[1]; float s = (a[0] + a[1]) + (a[2] + a[3]);
    s += __shfl_xor(s, 1); s += __shfl_xor(s, 2); s += __shfl_xor(s, 4); s += __shfl_xor(s, 8);
    if (sub == 0) stab[row] = s;
    __syncthreads();
}

#define XB_TMO      128
#define XB_XCNT(j)  (256  + 64 * (j))
#define XB_XSUB(j)  (1280 + 64 * (j))
#define XB_XGEN(j)  (2304 + 64 * (j))
#define XB_TOP      3328
#define XB_TOPGEN   3392
#define XCD_BAR_WORDS 3456
#define XB_SPIN_CAP (1u << 18)
__device__ __forceinline__ unsigned xb_ld(unsigned* p)              { return __hip_atomic_load(p, __ATOMIC_RELAXED, __HIP_MEMORY_SCOPE_AGENT); }
__device__ __forceinline__ unsigned xb_add(unsigned* p, unsigned v) { return __hip_atomic_fetch_add(p, v, __ATOMIC_RELAXED, __HIP_MEMORY_SCOPE_AGENT); }
__device__ __forceinline__ unsigned xb_xcc_id() { return (unsigned)__builtin_amdgcn_s_getreg((3 << 11) | 20) & 0xFu; }
#define XB_SPIN(cond, bar) do { unsigned _sp = 0; while (cond) { __builtin_amdgcn_s_sleep(1); \
    if ((++_sp & 255u) == 0u) { if (xb_ld(&(bar)[XB_TMO])) break; if (_sp > XB_SPIN_CAP) { atomicAdd(&(bar)[XB_TMO], 1u); break; } } } } while (0)
struct XcdBarrier { unsigned* bar; unsigned x; volatile LAS unsigned* st; };
__device__ __forceinline__ XcdBarrier xcd_barrier_post(unsigned* bar, volatile LAS unsigned* st) {
    XcdBarrier b; b.bar = bar; b.x = xb_xcc_id(); b.st = st;
    if (threadIdx.x == 0) (void)xb_add(&bar[XB_XCNT(b.x)], 1u);
    return b;
}
__device__ __forceinline__ void xcd_barrier_complete(unsigned* bar, unsigned x, unsigned& nloc, unsigned& nx) {
    const unsigned G = gridDim.x * gridDim.y * gridDim.z;
    unsigned sum, cnt, mine, sp = 0u;
    for (;;) {
        sum = 0u; cnt = 0u; mine = 0u;
#pragma unroll
        for (unsigned j = 0; j < 16; ++j) { const unsigned c = xb_ld(&bar[XB_XCNT(j)]); sum += c; cnt += (c > 0u) ? 1u : 0u; mine = (j == x) ? c : mine; }
        if (sum == G) break;
        __builtin_amdgcn_s_sleep(1);
        if ((++sp & 255u) == 0u) { if (xb_ld(&bar[XB_TMO])) break; if (sp > XB_SPIN_CAP) { atomicAdd(&bar[XB_TMO], 1u); break; } }
    }
    nloc = mine > 0u ? mine : 1u; nx = cnt > 0u ? cnt : 1u;
}
__device__ __forceinline__ void xcd_barrier(const XcdBarrier& b) {
    asm volatile("s_waitcnt vmcnt(0)" ::: "memory");
    __syncthreads();
    if (threadIdx.x == 0) {
        unsigned* bar = b.bar;
        __builtin_amdgcn_s_waitcnt(0);
        unsigned nloc = b.st[0], nx = b.st[1];
        if (nloc == 0u) { xcd_barrier_complete(bar, b.x, nloc, nx); b.st[0] = nloc; b.st[1] = nx; }
        const unsigned old = xb_add(&bar[XB_XSUB(b.x)], 1u);
        const unsigned gen = old / nloc;
        if (old + 1u == (gen + 1u) * nloc) {
            __builtin_amdgcn_fence(__ATOMIC_RELEASE, "agent");
            asm volatile("s_waitcnt vmcnt(0)" ::: "memory");
            const unsigned og = xb_add(&bar[XB_TOP], 1u);
            const unsigned tg = og / nx;
            if (og + 1u == (tg + 1u) * nx) xb_add(&bar[XB_TOPGEN], 1u);
            else XB_SPIN(xb_ld(&bar[XB_TOPGEN]) == tg, bar);
            __builtin_amdgcn_fence(__ATOMIC_ACQUIRE, "agent");
            xb_add(&bar[XB_XGEN(b.x)], 1u);
            asm volatile("s_waitcnt vmcnt(0)" ::: "memory");
        } else {
            XB_SPIN(xb_ld(&bar[XB_XGEN(b.x)]) == gen, bar);
            __builtin_amdgcn_fence(__ATOMIC_ACQUIRE, "agent");
            asm volatile("s_waitcnt vmcnt(0)" ::: "memory");
        }
    }
    __syncthreads();
}

struct Args { const float* in[24]; float* out; unsigned char* ws; int ph_lo, ph_hi, use_bar, pad; };
struct Frame {
    LAS unsigned char* lds; int tid, lane, wave, gw, NGW, vcu, G;
    const float* const* in; float* out; unsigned char* ws;
};

__device__ const double ROPE_REV[64] = {
    0.15915494309189535, 0.13782250260398285, 0.11934937021124886, 0.10335229661843406,
    0.08949940160889101, 0.07750328875537406, 0.06711508300522726, 0.058119267441876246,
    0.050329212104487035, 0.04358330210530733, 0.03774158471741977, 0.032682865872357,
    0.0283021958306234, 0.024508691862069852, 0.02122365276477766, 0.018378926105679667,
    0.015915494309189534, 0.013782250260398284, 0.011934937021124886, 0.010335229661843406,
    0.008949940160889102, 0.0077503288755374055, 0.006711508300522725, 0.005811926744187624,
    0.005032921210448704, 0.004358330210530733, 0.003774158471741977, 0.0032682865872356993,
    0.00283021958306234, 0.002450869186206985, 0.0021223652764777662, 0.0018378926105679667,
    0.0015915494309189536, 0.0013782250260398288, 0.0011934937021124885, 0.0010335229661843405,
    0.0008949940160889102, 0.0007750328875537405, 0.0006711508300522726, 0.0005811926744187624,
    0.0005032921210448703, 0.0004358330210530733, 0.00037741584717419774, 0.0003268286587235699,
    0.00028302195830623395, 0.00024508691862069854, 0.0002122365276477766, 0.00018378926105679666,
    0.00015915494309189535, 0.00013782250260398286, 0.00011934937021124886, 0.00010335229661843406,
    8.949940160889102e-05, 7.750328875537406e-05, 6.711508300522725e-05, 5.811926744187624e-05,
    5.0329212104487035e-05, 4.358330210530732e-05, 3.774158471741978e-05, 3.2682865872357e-05,
    2.8302195830623396e-05, 2.4508691862069852e-05, 2.122365276477766e-05, 1.8378926105679668e-05};

struct TrJob { const float* src; bf16_t* dst; const float* gn; int N, ldo; };
__device__ __forceinline__ void tr_load(const TrJob& J, int lane, f32x4 (&v)[8]) {
#pragma unroll
    for (int j = 0; j < 8; ++j) v[j] = __builtin_nontemporal_load((const f32x4*)(J.src + (size_t)((lane >> 3) + 8 * j) * J.N + 4 * (lane & 7)));
}
__device__ __forceinline__ void tr_flush(const TrJob& J, const f32x4 (&v)[8], LAS float* scr, int lane) {
#pragma unroll
    for (int j = 0; j < 8; ++j) { LAS float* d = scr + ((lane >> 3) + 8 * j) * 33 + 4 * (lane & 7); d[0] = v[j][0]; d[1] = v[j][1]; d[2] = v[j][2]; d[3] = v[j][3]; }
    LDS_WAIT(); asm volatile("" ::: "memory");
    const int c = lane & 7;
#pragma unroll
    for (int j = 0; j < 4; ++j) { const int n = (lane >> 3) + 8 * j; const LAS float* s = scr + (8 * c) * 33 + n; const float sn = J.gn ? J.gn[n] : 1.0f;
        u32x4 o; o.x = cvt_pk_bf16(s[0 * 33] * sn, s[1 * 33] * sn); o.y = cvt_pk_bf16(s[2 * 33] * sn, s[3 * 33] * sn); o.z = cvt_pk_bf16(s[4 * 33] * sn, s[5 * 33] * sn); o.w = cvt_pk_bf16(s[6 * 33] * sn, s[7 * 33] * sn);
        __builtin_nontemporal_store(o, (u32x4*)(J.dst + (size_t)n * J.ldo + 8 * c)); }
    LDS_WAIT(); asm volatile("" ::: "memory");
}
__device__ __forceinline__ TrJob tr_job(const float* W, int N, int k0, int n0, bf16_t* WT, int ldo, const float* gn = nullptr) {
    TrJob J; J.src = W + (size_t)k0 * N + n0; J.dst = WT; J.gn = gn ? gn + n0 : nullptr; J.N = N; J.ldo = ldo; return J;
}
__device__ __forceinline__ void tr_item(const float* W, int N, int k0, int n0, bf16_t* WT, int ldo, LAS float* scr, int lane, const float* gn = nullptr) {
    const TrJob J = tr_job(W, N, k0, n0, WT, ldo, gn); f32x4 v[8]; tr_load(J, lane, v); asm volatile("" ::: "memory"); tr_flush(J, v, scr, lane);
}
constexpr int I_IN = 32 * 344, I_OUT = 86 * 64, I_FFN = I_IN + I_OUT;
__device__ __forceinline__ TrJob ffn_job(Frame& F, int s, int r) {
    unsigned char* ws = F.ws;
    if (r < I_IN) { const int kb = r / 344, nb = r % 344, n0 = nb * 32;
        const float* W = F.in[(s & 1) ? 11 : 7] + (size_t)(s >> 1) * D * 2 * FF;
        const int j = n0 < FF ? n0 : n0 - FF; const int drow = (j >> 7) * 256 + (n0 < FF ? 0 : 128) + (j & 127);
        return tr_job(W, 2 * FF, kb * 64, n0, (bf16_t*)(ws + WS_WIN + (size_t)s * WIN_BYTES) + (size_t)drow * D + kb * 64, D); }
    else { const int q = r - I_IN, kb = q / 64, nb = q % 64;
        const float* W = F.in[(s & 1) ? 12 : 8] + (size_t)(s >> 1) * FF * D;
        return tr_job(W, D, kb * 64, nb * 32, (bf16_t*)(ws + WS_WOUT + (size_t)s * WOUT_BYTES) + (size_t)(nb * 32) * FF + kb * 64, FF); }
}
__device__ __forceinline__ TrJob mixw_job(Frame& F, int it);
#ifndef CONV_NT
#define CONV_NT 2
#endif
template <int KIND, int NT = CONV_NT> __device__ __forceinline__ void conv_run(Frame& F, int blk, int lo, int hi, int sw, int nsw, int lane) {
    LAS float* scr = (LAS float*)(F.lds + F.wave * 16384);
    for (int r = lo + sw; r < hi; r += NT * nsw) {
        TrJob J[NT]; f32x4 v[NT][8];
#pragma unroll
        for (int t = 0; t < NT; ++t) if (r + t * nsw < hi) { J[t] = KIND == 0 ? ffn_job(F, blk, r + t * nsw) : mixw_job(F, r + t * nsw); tr_load(J[t], lane, v[t]); }
        asm volatile("" ::: "memory");
#pragma unroll
        for (int t = 0; t < NT; ++t) if (r + t * nsw < hi) tr_flush(J[t], v[t], scr, lane);
    }
}
__device__ __forceinline__ void conv_block_range(Frame& F, int blk, int lo, int hi, int sw, int nsw, int lane) { conv_run<0>(F, blk, lo, hi, sw, nsw, lane); }
#ifndef SPW_F
#define SPW_F 10
#endif
#ifndef SPW_C
#define SPW_C 0
#endif
#ifndef SPW_Q
#define SPW_Q 10
#endif
constexpr int imin(int a, int b) { return a < b ? a : b; }
constexpr int CAP_F = 117 * 8 * SPW_F, CAP_C = 240 * 8 * SPW_C, CAP_Q = 184 * 8 * SPW_Q;
constexpr int TAILC = 128 * 8 * 4;
constexpr int DA = imin(CAP_F, I_FFN), D3 = imin(I_FFN, DA + CAP_C), D4 = imin(I_FFN, DA + (CAP_C - (D3 - DA))), D5 = imin(I_FFN, DA + CAP_Q), D6 = imin(I_FFN, DA + (CAP_Q - (D5 - DA)));
#ifndef MIXW_IN_SLACK
#define MIXW_IN_SLACK 1
#endif
constexpr int I_POOL = 8 * 16, I_CIN = 32 * 128, I_SQ = 32 * 64, I_QKV = 32 * 576, M_E3 = I_CIN, M_E4 = M_E3 + I_SQ, M_E5 = M_E4 + I_QKV, I_MIXW = M_E5 + I_SQ;
__device__ __forceinline__ TrJob mixw_job(Frame& F, int it) {
    unsigned char* ws = F.ws;
    if (it < M_E3) { const int r = it, kb = r / 128, nb = r % 128;
        return tr_job(F.in[15], 4096, kb * 64, nb * 32, (bf16_t*)(ws + WS_WCIN) + (size_t)(nb * 32) * D + kb * 64, D); }
    else if (it < M_E4) { const int r = it - M_E3, kb = r / 64, nb = r % 64;
        return tr_job(F.in[19], D, kb * 64, nb * 32, (bf16_t*)(ws + WS_WCOUT) + (size_t)(nb * 32) * D + kb * 64, D); }
    else if (it < M_E5) { const int r = it - M_E4, kb = r / 576, nb = r % 576, n0 = nb * 32, pn = n0 >> 8, i5 = (n0 >> 5) & 7;
        const int lam = pn < 48 ? (((i5 & 3) < 2 ? 0 : 128) + (i5 >> 2) * 64 + (i5 & 1) * 32) : (n0 & 255);
        return tr_job(F.in[20], NQKV, kb * 64, n0, (bf16_t*)(ws + WS_WQKV) + (size_t)(pn * 256 + lam) * D + kb * 64, D); }
    else { const int r = it - M_E5, kb = r / 64, nb = r % 64;
        return tr_job(F.in[23], D, kb * 64, nb * 32, (bf16_t*)(ws + WS_WAO) + (size_t)(nb * 32) * D + kb * 64, D); }
}
__device__ __forceinline__ const float* x_row_src(Frame& F, int m) { return m < MPR ? F.in[0] + (size_t)m * D : (m < MR ? F.in[1] + (size_t)(m - MPR) * D : nullptr); }
__device__ __forceinline__ void x_row_load(const float* src, int lane, f32x4 (&v)[8]) {
#pragma unroll
    for (int j = 0; j < 8; ++j) v[j] = src ? *(const f32x4*)(src + 4 * lane + 256 * j) : (f32x4){0.f, 0.f, 0.f, 0.f};
}
__device__ __forceinline__ void x_row_store(Frame& F, int m, const f32x4 (&vin)[8]) {
    unsigned char* ws = F.ws; float* X = (float*)(ws + WS_X); bf16_t* XB = (bf16_t*)(ws + WS_XB); float* part = (float*)(ws + WS_PART); const float* g0 = F.in[6];
    float ss = 0.f;
#pragma unroll
    for (int j = 0; j < 8; ++j) { const int c = 4 * F.lane + 256 * j; f32x4 v = vin[j];
        ss += (v[0] * v[0] + v[1] * v[1]) + (v[2] * v[2] + v[3] * v[3]);
        if (m >= MPR) *(f32x4*)(X + (size_t)m * D + c) = v;
        const f32x4 g = *(const f32x4*)(g0 + c); v = v * g;
        u32x2 w; w.x = cvt_pk_bf16(v[0], v[1]); w.y = cvt_pk_bf16(v[2], v[3]); *(u32x2*)(XB + (size_t)m * D + c) = w; }
    ss = wave_sum(ss);
    if (F.lane < 8) part[(size_t)m * 8 + F.lane] = F.lane == 0 ? ss : 0.f;
    if (m >= MPR && m < MR) { float* sp = (float*)(ws + WS_SPART) + (size_t)(m - MPR) * 128; sp[F.lane] = F.lane == 0 ? ss : 0.f; sp[64 + F.lane] = 0.f; }
}
__device__ __forceinline__ void p0_prologue(Frame& F) {
    LAS float* scr = (LAS float*)(F.lds + F.wave * 16384);
    unsigned char* ws = F.ws;
    conv_run<0, 4>(F, 0, 0, I_FFN, F.gw, F.NGW, F.lane);
#pragma unroll 1
    for (int b = 5; b < 7; ++b) { const int lo0 = b == 3 ? D3 : b == 4 ? D4 : b == 5 ? D5 : b == 6 ? D6 : DA; const int lo = imin(lo0 + TAILC, I_FFN);
        conv_block_range(F, b, lo, I_FFN, F.gw, F.NGW, F.lane); }
    for (int it = F.gw; it < 8 * I_POOL; it += F.NGW) { const int jg = it / I_POOL, r = it % I_POOL, kb = r / 16, nb = r % 16;
        const float* W = F.in[13] + (size_t)jg * 512 * 512;
        tr_item(W, 512, kb * 64, nb * 32, (bf16_t*)(ws + WS_WPOOL + (size_t)(jg >> 2) * WPOOL_BYTES) + (size_t)((jg & 3) * 512 + nb * 32) * 512 + kb * 64, 512, scr, F.lane, F.in[14] + (size_t)(jg >> 2) * D + (jg & 3) * 512); }
#if !MIXW_IN_SLACK
    conv_run<1>(F, 0, 0, I_MIXW, F.gw, F.NGW, F.lane);
#endif
    { float* cst = (float*)(ws + WS_CS);
      for (int pi = F.gw; pi < SEQ + DEC_T; pi += F.NGW) { const int pos = pi < SEQ ? pi : PAST + (pi - SEQ);
          double a = (double)pos * ROPE_REV[F.lane]; a -= rint(a); const float rv = (float)a; cst[(size_t)pi * 128 + F.lane] = __builtin_amdgcn_cosf(rv); cst[(size_t)pi * 128 + 64 + F.lane] = __builtin_amdgcn_sinf(rv); } }
    { const float* w = F.in[17]; bf16_t* o = (bf16_t*)(ws + WS_WSB);
      for (int i = F.gw * 64 + F.lane; i < 8 * 128 * 128; i += F.NGW * 64) { const int q = (i >> 7) & 127, c = i & 127; const float v = c <= q ? w[i] : 0.f; o[i] = (bf16_t)(cvt_pk_bf16(v, 0.f) & 0xffffu); } }
    for (int m0 = F.gw; m0 < MPAD; m0 += 2 * F.NGW) { const int m1 = m0 + F.NGW;
        f32x4 va[8], vb[8];
        x_row_load(x_row_src(F, m0), F.lane, va);
        if (m1 < MPAD) x_row_load(x_row_src(F, m1), F.lane, vb);
        asm volatile("" ::: "memory");
        x_row_store(F, m0, va);
        if (m1 < MPAD) x_row_store(F, m1, vb);
    }
}

__device__ __forceinline__ float row_rstd8(const float* part, int row) {
    const f32x4* p = (const f32x4*)(part + (size_t)row * 8); const f32x4 a = p[0] + p[1];
    return rsqrtf(((a[0] + a[1]) + (a[2] + a[3])) * (1.0f / 2048.0f) + EPS);
}
__device__ __forceinline__ float row_rstd32(const float* part, int row) {
    const f32x4* p = (const f32x4*)(part + (size_t)row * 32); f32x4 a = p[0];
#pragma unroll
    for (int i = 1; i < 8; ++i) a += p[i];
    return rsqrtf(((a[0] + a[1]) + (a[2] + a[3])) * (1.0f / 2048.0f) + EPS);
}

template <int W> __device__ __forceinline__ void pool_prompt_item(Frame& F, int lane, int b, int t0, int cb, int j, const float* gmix) {
    const float* X = (const float*)(F.ws + WS_X); const float* part = (const float*)(F.ws + WS_PART); bf16_t* P = (bf16_t*)(F.ws + WS_POOLED);
    const int col = cb * 256 + 4 * lane; const f32x4 g = *(const f32x4*)(gmix + col);
    const int tl = t0 - 15 + lane;
    float rsv = 0.f; if (lane < 47 && tl >= 0) rsv = row_rstd8(part, b * SEQ + tl);
    const int rsi = __float_as_int(rsv);
    f32x4 h[16];
#pragma unroll
    for (int k = 0; k < 16; ++k) h[k] = (f32x4){0.f, 0.f, 0.f, 0.f};
#pragma unroll 1
    for (int base = 0; base < 48; base += 16) {
        f32x4 xr[16];
#pragma unroll
        for (int k = 0; k < 16; ++k) { const int i = base + k, t = t0 - 15 + i; xr[k] = (f32x4){0.f, 0.f, 0.f, 0.f}; if (i < 47 && t >= 0) xr[k] = *(const f32x4*)(X + (size_t)(b * SEQ + t) * D + col); }
        asm volatile("" ::: "memory");
#pragma unroll
        for (int k = 0; k < 16; ++k) {
            const int i = base + k, t = t0 - 15 + i;
            if (i < 47) {
                const f32x4 hn = xr[k] * __int_as_float(__builtin_amdgcn_readlane(rsi, i)); h[k] = hn;
                if (i >= 15) {
                    f32x4 s = hn;
#pragma unroll
                    for (int q = 1; q < W; ++q) s += h[(k - q) & 15];
                    const int cnt = (t + 1) < W ? (t + 1) : W; const float inv = 1.0f / (float)cnt;
                    const f32x4 hg = hn * g, o = s * g * inv - hg; u32x2 w; w.x = cvt_pk_bf16(o[0], o[1]); w.y = cvt_pk_bf16(o[2], o[3]);
                    *(u32x2*)(P + (size_t)(b * SEQ + t) * D + col) = w;
                    if (t >= SEQ - 15) *(f32x4*)(F.out + O_PP + ((size_t)(j * NBATCH + b) * 15 + (t - (SEQ - 15))) * D + col) = hg;
                }
            }
        }
    }
}
template <int W> __device__ __forceinline__ void pool_sample_item(Frame& F, int lane, int b, int cb, int j, const float* gmix) {
    const float* X = (const float*)(F.ws + WS_X); bf16_t* P = (bf16_t*)(F.ws + WS_POOLED);
    const float* st = F.in[2] + ((size_t)(j * DEC_B + b) * 15) * D;
    const int col = cb * 256 + 4 * lane; const f32x4 g = *(const f32x4*)(gmix + col);
    f32x4 hb[19];
#pragma unroll
    for (int i = 0; i < 15; ++i) hb[i] = *(const f32x4*)(st + (size_t)i * D + col);
#pragma unroll
    for (int i = 0; i < 4; ++i) hb[15 + i] = *(const f32x4*)(X + (size_t)(MPR + b * 4 + i) * D + col);
    float rsv = 0.f;
    if (lane < 4) { const f32x4* sp = (const f32x4*)((const float*)(F.ws + WS_SPART) + (size_t)(b * 4 + lane) * 128); f32x4 a = sp[0];
#pragma unroll
        for (int i = 1; i < 32; ++i) a += sp[i];
        rsv = rsqrtf(((a[0] + a[1]) + (a[2] + a[3])) * (1.0f / 2048.0f) + EPS); }
    asm volatile("" ::: "memory");
    const int rsi = __float_as_int(rsv);
#pragma unroll
    for (int i = 0; i < 4; ++i) hb[15 + i] = hb[15 + i] * __int_as_float(__builtin_amdgcn_readlane(rsi, i)) * g;
#pragma unroll
    for (int i = 4; i < 19; ++i) *(f32x4*)(F.out + O_PS + ((size_t)(j * DEC_B + b) * 15 + (i - 4)) * D + col) = hb[i];
#pragma unroll
    for (int i = 15; i < 19; ++i) {
        f32x4 s = hb[i];
#pragma unroll
        for (int q = 1; q < W; ++q) s += hb[i - q];
        const f32x4 o = s * (1.0f / (float)W) - hb[i]; u32x2 w; w.x = cvt_pk_bf16(o[0], o[1]); w.y = cvt_pk_bf16(o[2], o[3]);
        *(u32x2*)(P + (size_t)(MPR + b * 4 + (i - 15)) * D + col) = w;
    }
}
__device__ __forceinline__ void pool_phase(Frame& F, int j, const float* gmix) {
    constexpr int NP = NBATCH * 64 * 8, NS = DEC_B * 8, NZ = (MPAD - MR);
    int lane = F.lane; asm volatile("" : "+v"(lane));
    for (int it = F.gw; it < NP + NS + NZ; it += F.NGW) {
        if (it < NP) { const int cb = it & 7, seg = (it >> 3) & 63, b = it >> 9;
            switch (cb >> 1) { case 0: pool_prompt_item<2>(F, lane, b, seg * 32, cb, j, gmix); break; case 1: pool_prompt_item<4>(F, lane, b, seg * 32, cb, j, gmix); break;
                               case 2: pool_prompt_item<8>(F, lane, b, seg * 32, cb, j, gmix); break; default: pool_prompt_item<16>(F, lane, b, seg * 32, cb, j, gmix); break; } }
        else if (it < NP + NS) { const int q = it - NP, cb = q & 7, b = q >> 3;
            switch (cb >> 1) { case 0: pool_sample_item<2>(F, lane, b, cb, j, gmix); break; case 1: pool_sample_item<4>(F, lane, b, cb, j, gmix); break;
                               case 2: pool_sample_item<8>(F, lane, b, cb, j, gmix); break; default: pool_sample_item<16>(F, lane, b, cb, j, gmix); break; } }
        else { const int row = MR + (it - NP - NS); u32x4* p = (u32x4*)((bf16_t*)(F.ws + WS_POOLED) + (size_t)row * D);
#pragma unroll
            for (int k = 0; k < 4; ++k) p[lane + 64 * k] = (u32x4){0u, 0u, 0u, 0u}; }
    }
}

__device__ __forceinline__ void chunk_mix_phase(Frame& F) {
    constexpr int VP = 264;
    LAS bf16_t* VT = (LAS bf16_t*)F.lds;
    LAS float* rsv = (LAS float*)(F.lds + 70656);
    const bf16_t* U = (const bf16_t*)(F.ws + WS_U); const bf16_t* V = (const bf16_t*)(F.ws + WS_V); bf16_t* Y = (bf16_t*)(F.ws + WS_Y);
    const float* vpart = (const float*)(F.ws + WS_VPART); const bf16_t* WSB = (const bf16_t*)(F.ws + WS_WSB);
    const float* vg = F.in[16]; const float* bs = F.in[18];
    int l = F.lane; asm volatile("" : "+v"(l)); const int w = F.wave, fr = l & 15, fq = l >> 4, tid = w * 64 + l;
    constexpr int NPI = 64 * 8, NSI = DEC_B * 8;
    for (int it = F.vcu; it < NPI + NSI; it += F.G) {
        const bool smp = it >= NPI; const int g = it & 7; const int ch = smp ? (it - NPI) >> 3 : it >> 3;
        const int R0 = smp ? MPR + ch * 4 : ch * 128; const int nrows = smp ? 4 : 128;
        __syncthreads();
        if (tid < 128) { float rv = 0.f;
            if (tid < nrows) { if (smp) { const f32x4* sp = (const f32x4*)((const float*)(F.ws + WS_SVPART) + (size_t)(ch * 4 + tid) * 128); f32x4 a = sp[0];
#pragma unroll
                    for (int i = 1; i < 32; ++i) a += sp[i];
                    rv = rsqrtf(((a[0] + a[1]) + (a[2] + a[3])) * (1.0f / 2048.0f) + EPS); }
                else rv = row_rstd32(vpart, R0 + tid); }
            rsv[tid] = rv; }
        __syncthreads();
        u32x4 raw[8];
#pragma unroll
        for (int it8 = 0; it8 < 8; ++it8) { const int q = tid + 512 * it8, c = q >> 5, k = q & 31; raw[it8] = (u32x4){0u, 0u, 0u, 0u}; if (c < nrows) raw[it8] = *(const u32x4*)(V + (size_t)(R0 + c) * D + g * 256 + 8 * k); }
        asm volatile("" ::: "memory");
#pragma unroll
        for (int it8 = 0; it8 < 8; ++it8) {
            const int q = tid + 512 * it8, c = q >> 5, k = q & 31; float v[8];
            if (c < nrows) { const u32x4 rw = raw[it8]; const float rs = rsv[c];
                const f32x4 g0 = *(const f32x4*)(vg + g * 256 + 8 * k), g1 = *(const f32x4*)(vg + g * 256 + 8 * k + 4);
                v[0] = bflo(rw.x) * rs * g0[0]; v[1] = bfhi(rw.x) * rs * g0[1]; v[2] = bflo(rw.y) * rs * g0[2]; v[3] = bfhi(rw.y) * rs * g0[3];
                v[4] = bflo(rw.z) * rs * g1[0]; v[5] = bfhi(rw.z) * rs * g1[1]; v[6] = bflo(rw.w) * rs * g1[2]; v[7] = bfhi(rw.w) * rs * g1[3];
                if (smp) { float* o = F.out + O_CV + (size_t)(ch * 4 + c) * D + g * 256 + 8 * k; *(f32x4*)o = (f32x4){v[0], v[1], v[2], v[3]}; *(f32x4*)(o + 4) = (f32x4){v[4], v[5], v[6], v[7]}; }
            } else {
#pragma unroll
                for (int e = 0; e < 8; ++e) v[e] = 0.f; }
            u32x4 pk; pk.x = cvt_pk_bf16(v[0], v[1]); pk.y = cvt_pk_bf16(v[2], v[3]); pk.z = cvt_pk_bf16(v[4], v[5]); pk.w = cvt_pk_bf16(v[6], v[7]);
            *(LAS u32x4*)(VT + c * VP + 8 * k) = pk;
        }
        __syncthreads();
        const int nqt = smp ? 1 : 8, ncs = smp ? 1 : 4;
        f32x4 acc[2][8];
#pragma unroll
        for (int a = 0; a < 2; ++a)
#pragma unroll
            for (int b = 0; b < 8; ++b) acc[a][b] = (f32x4){0.f, 0.f, 0.f, 0.f};
        for (int cs = 0; cs < ncs; ++cs) {
            bf16x8 xf[2];
#pragma unroll
            for (int dt = 0; dt < 2; ++dt) { const LAS bf16_t* vp = VT + (32 * cs + 8 * fq) * VP + 32 * w + 16 * dt + fr; u32x4 t;
                t.x = (unsigned)vp[0 * VP] | ((unsigned)vp[1 * VP] << 16); t.y = (unsigned)vp[2 * VP] | ((unsigned)vp[3 * VP] << 16);
                t.z = (unsigned)vp[4 * VP] | ((unsigned)vp[5 * VP] << 16); t.w = (unsigned)vp[6 * VP] | ((unsigned)vp[7 * VP] << 16);
                xf[dt] = __builtin_bit_cast(bf16x8, t); }
            bf16x8 yf[8];
#pragma unroll
            for (int qt = 0; qt < 8; ++qt) if (qt < nqt && 16 * qt + 15 >= 32 * cs) yf[qt] = *(const bf16x8*)(WSB + ((size_t)g * 128 + 16 * qt + fr) * 128 + 32 * cs + 8 * fq);
            asm volatile("" ::: "memory");
#pragma unroll
            for (int qt = 0; qt < 8; ++qt) {
                if (qt < nqt && 16 * qt + 15 >= 32 * cs) {
#pragma unroll
                    for (int dt = 0; dt < 2; ++dt) acc[dt][qt] = __builtin_amdgcn_mfma_f32_16x16x32_bf16(xf[dt], yf[qt], acc[dt][qt], 0, 0, 0);
                }
            }
        }
        u32x2 uu[2][8]; float bq[8];
#pragma unroll
        for (int qt = 0; qt < 8; ++qt) { const int q = 16 * qt + fr; bq[qt] = 0.f;
            if (qt < nqt && q < nrows) { bq[qt] = bs[g * 128 + q];
#pragma unroll
                for (int dt = 0; dt < 2; ++dt) uu[dt][qt] = *(const u32x2*)(U + (size_t)(R0 + q) * D + g * 256 + 32 * w + 16 * dt + 4 * fq); } }
        asm volatile("" ::: "memory");
#pragma unroll
        for (int qt = 0; qt < 8; ++qt) { const int q = 16 * qt + fr;
            if (qt < nqt && q < nrows) {
#pragma unroll
                for (int dt = 0; dt < 2; ++dt) { const size_t off = (size_t)(R0 + q) * D + g * 256 + 32 * w + 16 * dt + 4 * fq;
                    const u32x2 u2 = uu[dt][qt]; const f32x4 mx = acc[dt][qt] + bq[qt];
                    u32x2 o; o.x = cvt_pk_bf16(bflo(u2.x) * mx[0], bfhi(u2.x) * mx[1]); o.y = cvt_pk_bf16(bflo(u2.y) * mx[2], bfhi(u2.y) * mx[3]);
                    *(u32x2*)(Y + off) = o; } } }
    }
    for (int r = MR + F.gw; r < MPAD; r += F.NGW) { u32x4* p = (u32x4*)(Y + (size_t)r * D);
#pragma unroll
        for (int k = 0; k < 4; ++k) p[l + 64 * k] = (u32x4){0u, 0u, 0u, 0u}; }
}


__device__ __forceinline__ int attn_swk(int rho) { return (rho & 3) | (((rho >> 3) & 3) << 2); }
struct AttnRegs { u32x4 kc[8], vc[8]; };
__device__ __forceinline__ void attn_item_load(Frame& F, int item, int l, int w, AttnRegs& R) {
    const bf16_t* KP = (const bf16_t*)(F.ws + WS_KP); const bf16_t* VBp = (const bf16_t*)(F.ws + WS_VB);
    const int tid = w * 64 + l;
    const int g = item >> 10, rem = item & 1023, b = rem >> 8, h = (rem >> 4) & 15, sb = rem & 15;
    const int sh = 2 * g, dil = 1 << sh, spr = 16 >> sh, r = sb / spr, st = sb % spr;
    const size_t rowstride = (size_t)dil * AW;
    const bf16_t* Kb = KP + (size_t)(b * SEQ + r) * AW + (g * 16 + h) * 128;
    const bf16_t* Vb = VBp + (size_t)(b * SEQ + r) * AW + (g * 16 + h) * 128;
    const int kap0 = 128 * st - 128;
#pragma unroll
    for (int j = 0; j < 8; ++j) { const int q = tid + 512 * j, rho = q >> 4, c = q & 15, kap = kap0 + rho; R.kc[j] = (u32x4){0u, 0u, 0u, 0u};
        if (kap >= 0) R.kc[j] = *(const u32x4*)(Kb + (size_t)kap * rowstride + 8 * c); }
#pragma unroll
    for (int j = 0; j < 8; ++j) { const int idx = w * 8 + j, rho = 8 * (idx >> 1) + (l >> 3), c = 2 * (l & 7) + (idx & 1), kap = kap0 + rho; R.vc[j] = (u32x4){0u, 0u, 0u, 0u};
        if (kap >= 0) R.vc[j] = *(const u32x4*)(Vb + (size_t)kap * rowstride + 8 * c); }
}
__device__ __forceinline__ void attn_item_compute(Frame& F, int item, int nxt, int l, int w, AttnRegs& R) {
    bf16_t* OG = (bf16_t*)(F.ws + WS_OG); float* LSE = (float*)(F.ws + WS_LSE);
    LAS unsigned char* Kl = F.lds; LAS unsigned char* Vl = F.lds + 65536;
    const int fr = l & 15, fq = l >> 4, tid = w * 64 + l;
    const int g = item >> 10, rem = item & 1023, b = rem >> 8, h = (rem >> 4) & 15, sb = rem & 15;
    const int sh = 2 * g, dil = 1 << sh, spr = 16 >> sh, r = sb / spr, st = sb % spr;
    const size_t rowstride = (size_t)dil * AW;
    const int kap0 = 128 * st - 128;
    const int irow = 128 * st + 16 * w + fr;
    bf16x8 qf[4];
    { const bf16_t* Qb = (const bf16_t*)(F.ws + WS_QP) + (size_t)(b * SEQ + r) * AW + (g * 16 + h) * 128;
#pragma unroll
      for (int es = 0; es < 4; ++es) qf[es] = *(const bf16x8*)(Qb + (size_t)irow * rowstride + 32 * es + 8 * fq); }
    asm volatile("" ::: "memory");
    __syncthreads();
#pragma unroll
    for (int j = 0; j < 8; ++j) { const int q = tid + 512 * j, rho = q >> 4, c = q & 15; *(LAS u32x4*)(Kl + rho * 256 + ((c ^ attn_swk(rho)) << 4)) = R.kc[j]; }
#pragma unroll
    for (int j = 0; j < 8; ++j) { const int idx = w * 8 + j, rho = 8 * (idx >> 1) + (l >> 3), c = 2 * (l & 7) + (idx & 1);
        const unsigned wv[4] = {R.vc[j].x, R.vc[j].y, R.vc[j].z, R.vc[j].w};
#pragma unroll
        for (int e = 0; e < 8; ++e) { const int d = 8 * c + e; *(LAS bf16_t*)(Vl + d * 512 + ((((rho >> 3) ^ (d & 15) ^ (d >> 4)) << 4) + (rho & 7) * 2)) = (bf16_t)((e & 1) ? (wv[e >> 1] >> 16) : (wv[e >> 1] & 0xffffu)); } }
    __syncthreads();
    if (nxt >= 0) attn_item_load(F, nxt, l, w, R);
    asm volatile("" ::: "memory");
    float mrun = -1e30f, lrun = 0.f;
    f32x4 O[8];
#pragma unroll
    for (int dt = 0; dt < 8; ++dt) O[dt] = (f32x4){0.f, 0.f, 0.f, 0.f};
    const int lam_i = 128 + 16 * w + fr;
#pragma unroll 1
    for (int s = 0; s < 5; ++s) {
        const int lam0 = 32 * ((w >> 1) + s);
        if (kap0 + lam0 < 0) continue;
        f32x4 S[2];
#pragma unroll
        for (int p = 0; p < 2; ++p) { S[p] = (f32x4){0.f, 0.f, 0.f, 0.f}; const int rho = lam0 + 8 * (fr >> 2) + 4 * p + (fr & 3); const int swz = attn_swk(rho);
#pragma unroll
            for (int es = 0; es < 4; ++es) { const bf16x8 kf = *(const LAS bf16x8*)(Kl + rho * 256 + (((4 * es + fq) ^ swz) << 4)); S[p] = __builtin_amdgcn_mfma_f32_16x16x32_bf16(kf, qf[es], S[p], 0, 0, 0); } }
        if (s == 0 || s == 4) {
#pragma unroll
            for (int p = 0; p < 2; ++p)
#pragma unroll
                for (int e = 0; e < 4; ++e) { const int lam = lam0 + 8 * fq + 4 * p + e; if (lam > lam_i || lam < lam_i - 128) S[p][e] = -__builtin_inff(); }
        }
        float mx = fmaxf(fmaxf(fmaxf(S[0][0], S[0][1]), fmaxf(S[0][2], S[0][3])), fmaxf(fmaxf(S[1][0], S[1][1]), fmaxf(S[1][2], S[1][3])));
        mx = fmaxf(mx, __shfl_xor(mx, 16)); mx = fmaxf(mx, __shfl_xor(mx, 32));
        const float mn = fmaxf(mrun, mx), al = __builtin_amdgcn_exp2f(mrun - mn); mrun = mn;
        float pv[8], ps = 0.f;
#pragma unroll
        for (int p = 0; p < 2; ++p)
#pragma unroll
            for (int e = 0; e < 4; ++e) { pv[4 * p + e] = __builtin_amdgcn_exp2f(S[p][e] - mn); ps += pv[4 * p + e]; }
        lrun = lrun * al + ps;
        u32x4 pk; pk.x = cvt_pk_bf16(pv[0], pv[1]); pk.y = cvt_pk_bf16(pv[2], pv[3]); pk.z = cvt_pk_bf16(pv[4], pv[5]); pk.w = cvt_pk_bf16(pv[6], pv[7]);
        const bf16x8 pf = __builtin_bit_cast(bf16x8, pk);
        const int vch = (lam0 >> 3) + fq;
#pragma unroll
        for (int dt = 0; dt < 8; ++dt) { const int d = 16 * dt + fr; const bf16x8 vf = *(const LAS bf16x8*)(Vl + d * 512 + ((vch ^ (d & 15) ^ (d >> 4)) << 4));
            O[dt] = __builtin_amdgcn_mfma_f32_16x16x32_bf16(vf, pf, O[dt] * al, 0, 0, 0); }
    }
    float lt = lrun; lt += __shfl_xor(lt, 16); lt += __shfl_xor(lt, 32);
    const float inv = 1.0f / lt; const int row = b * SEQ + dil * irow + r;
    bf16_t* o = OG + ((size_t)g * MPAD + row) * D + h * 128 + 4 * fq;
#pragma unroll
    for (int dt = 0; dt < 8; ++dt) { const f32x4 v = O[dt] * inv; u32x2 w2; w2.x = cvt_pk_bf16(v[0], v[1]); w2.y = cvt_pk_bf16(v[2], v[3]); *(u32x2*)(o + 16 * dt) = w2; }
    if (fq == 0) LSE[((size_t)g * MPAD + row) * 16 + h] = (mrun + __log2f(lt)) * LN2;
}
__device__ __forceinline__ void attn_sample_item(Frame& F, int item) {
    const bf16_t* QP = (const bf16_t*)(F.ws + WS_QP); bf16_t* OG = (bf16_t*)(F.ws + WS_OG); float* LSE = (float*)(F.ws + WS_LSE);
    int l = F.lane; asm volatile("" : "+v"(l));
    const int half = l >> 5, c = l & 31;
    const int h = item & 15, g = (item >> 4) % 3, bt = item / 48, b = bt >> 2, t = bt & 3;
    const int sh = 2 * g, dil = 1 << sh, L = 128 << sh;
    const float* cache = F.in[3 + g] + (size_t)b * L * 4096 + h * 128 + 4 * c;
    const float* fresh = F.out + (g == 0 ? O_K0S : (g == 1 ? O_K1S : O_K2S)) + (size_t)(b * 4) * 4096 + h * 128 + 4 * c;
    const int row = MPR + b * 4 + t;
    f32x4 q; { const u32x2 w = *(const u32x2*)(QP + (size_t)row * AW + (g * 16 + h) * 128 + 4 * c); q = (f32x4){bflo(w.x), bfhi(w.x), bflo(w.y), bfhi(w.y)}; }
    float s0 = -__builtin_inff(), s1 = s0, s2 = s0;
    const float* kp64 = cache + (size_t)(half == 0 ? t : 0) * 4096;
#pragma unroll 1
    for (int jb = 0; jb < 2; ++jb) {
        f32x4 kv[32];
#pragma unroll
        for (int u = 0; u < 32; ++u) { const int j = 2 * (32 * jb + u) + half; const int idx = L + t - dil * j;
            kv[u] = *(const f32x4*)(idx >= L ? fresh + (size_t)(idx - L) * 4096 : cache + (size_t)idx * 4096); }
        const f32x4 k64 = *(const f32x4*)kp64;
        asm volatile("" ::: "memory");
#pragma unroll
        for (int u = 0; u < 32; ++u) {
            float s = (q[0] * kv[u][0] + q[1] * kv[u][1]) + (q[2] * kv[u][2] + q[3] * kv[u][3]);
            s += __shfl_xor(s, 1); s += __shfl_xor(s, 2); s += __shfl_xor(s, 4); s += __shfl_xor(s, 8); s += __shfl_xor(s, 16);
            const bool mine = c == u;
            if (jb == 0) s0 = mine ? s : s0; else s1 = mine ? s : s1; }
        if (jb == 1) { float s = (q[0] * k64[0] + q[1] * k64[1]) + (q[2] * k64[2] + q[3] * k64[3]);
            s += __shfl_xor(s, 1); s += __shfl_xor(s, 2); s += __shfl_xor(s, 4); s += __shfl_xor(s, 8); s += __shfl_xor(s, 16);
            if (c == 0 && half == 0) s2 = s; }
    }
    float mx = fmaxf(s0, fmaxf(s1, s2));
#pragma unroll
    for (int o = 1; o < 64; o <<= 1) mx = fmaxf(mx, __shfl_xor(mx, o));
    const float p0 = __builtin_amdgcn_exp2f(s0 - mx), p1 = __builtin_amdgcn_exp2f(s1 - mx), p2 = __builtin_amdgcn_exp2f(s2 - mx);
    const float ls = wave_sum(p0 + p1 + p2);
    f32x4 o = (f32x4){0.f, 0.f, 0.f, 0.f};
#pragma unroll 1
    for (int jb = 0; jb < 2; ++jb) {
        f32x4 vv[32];
#pragma unroll
        for (int u = 0; u < 32; ++u) { const int j = 2 * (32 * jb + u) + half; const int idx = L + t - dil * j;
            vv[u] = *(const f32x4*)((idx >= L ? fresh + (size_t)(idx - L) * 4096 : cache + (size_t)idx * 4096) + 2048); }
        const f32x4 v64 = *(const f32x4*)(kp64 + 2048);
        asm volatile("" ::: "memory");
        const float psel = jb == 0 ? p0 : p1;
#pragma unroll
        for (int u = 0; u < 32; ++u) { const float pj = __shfl(psel, (l & 32) | u); o += vv[u] * pj; }
        if (jb == 1) { const float pj = __shfl(p2, l & 32); o += v64 * pj; }
    }
#pragma unroll
    for (int k = 0; k < 4; ++k) o[k] += __shfl_xor(o[k], 32);
    const float inv = 1.0f / ls;
    if (half == 0) { u32x2 w; w.x = cvt_pk_bf16(o[0] * inv, o[1] * inv); w.y = cvt_pk_bf16(o[2] * inv, o[3] * inv); *(u32x2*)(OG + ((size_t)g * MPAD + row) * D + h * 128 + 4 * c) = w;
        if (c == 0) LSE[((size_t)g * MPAD + row) * 16 + h] = (mx + __log2f(ls)) * LN2; }
}
__device__ __forceinline__ void attn_phase(Frame& F) {
    constexpr int NPI = 3 * 1024, NSI = DEC_B * DEC_T * 3 * 16;
    int l = F.lane; asm volatile("" : "+v"(l));
#ifndef SKIP_ATTN_P
#ifndef REP_AP
#define REP_AP 1
#endif
#ifndef REP_AS
#define REP_AS 1
#endif
    for (int rp = 0; rp < REP_AP; ++rp) {
        AttnRegs Ra;
        static_assert(NPI == 12 * 256, "attention prompt items");
        const int pr = F.vcu >> 1, sg = pr % 3;
        const int ne = F.vcu >= 192 ? 4 : (sg == 2 ? 0 : 2);
        const int xb = F.vcu >= 192 ? 2816 + (F.vcu - 192) * 4 : 2560 + (((pr / 3) * 2 + sg) * 2 + (F.vcu & 1)) * 2;
        const int n = F.G == 256 ? 10 + ne : 0;
#define ATT_ITEM(k) ((k) < 10 ? F.vcu + 256 * (k) : xb + ((k) - 10))
        if (F.G == 256) {
            attn_item_load(F, ATT_ITEM(0), l, F.wave, Ra);
            asm volatile("" ::: "memory");
#pragma unroll 1
            for (int k = 0; k < n; ++k) attn_item_compute(F, ATT_ITEM(k), k + 1 < n ? ATT_ITEM(k + 1) : -1, l, F.wave, Ra);
        }
#undef ATT_ITEM
    }
    __syncthreads();
#endif
    const int wg = F.vcu * 8 + F.wave;
#ifndef SKIP_ATTN_S
    for (int rp = 0; rp < REP_AS; ++rp)
    for (int it = wg; it < NSI; it += F.NGW) attn_sample_item(F, it);
#endif
}
__device__ __forceinline__ void attn_combine_phase(Frame& F) {
    const bf16_t* OG = (const bf16_t*)(F.ws + WS_OG); const float* LSE = (const float*)(F.ws + WS_LSE); bf16_t* OC = (bf16_t*)(F.ws + WS_OC);
    int l = F.lane; asm volatile("" : "+v"(l)); const int h = l >> 2;
    for (int r = F.gw; r < MPAD; r += F.NGW) {
        u32x4* dst = (u32x4*)(OC + (size_t)r * D + 32 * l);
        if (r >= MR) {
#pragma unroll
            for (int k = 0; k < 4; ++k) dst[k] = (u32x4){0u, 0u, 0u, 0u}; continue; }
        const float l0 = LSE[((size_t)0 * MPAD + r) * 16 + h], l1 = LSE[((size_t)1 * MPAD + r) * 16 + h], l2 = LSE[((size_t)2 * MPAD + r) * 16 + h];
        const float mx = fmaxf(l0, fmaxf(l1, l2)); float w0 = __expf(l0 - mx), w1 = __expf(l1 - mx), w2 = __expf(l2 - mx); const float inv = 1.0f / (w0 + w1 + w2); w0 *= inv; w1 *= inv; w2 *= inv;
        const u32x4* s0 = (const u32x4*)(OG + ((size_t)0 * MPAD + r) * D + 32 * l); const u32x4* s1 = (const u32x4*)(OG + ((size_t)1 * MPAD + r) * D + 32 * l); const u32x4* s2 = (const u32x4*)(OG + ((size_t)2 * MPAD + r) * D + 32 * l);
        u32x4 va[4], vb[4], vc[4];
#pragma unroll
        for (int k = 0; k < 4; ++k) { va[k] = s0[k]; vb[k] = s1[k]; vc[k] = s2[k]; }
        asm volatile("" ::: "memory");
#pragma unroll
        for (int k = 0; k < 4; ++k) { const u32x4 a = va[k], bq = vb[k], c = vc[k]; u32x4 o;
            o.x = cvt_pk_bf16(bflo(a.x) * w0 + bflo(bq.x) * w1 + bflo(c.x) * w2, bfhi(a.x) * w0 + bfhi(bq.x) * w1 + bfhi(c.x) * w2);
            o.y = cvt_pk_bf16(bflo(a.y) * w0 + bflo(bq.y) * w1 + bflo(c.y) * w2, bfhi(a.y) * w0 + bfhi(bq.y) * w1 + bfhi(c.y) * w2);
            o.z = cvt_pk_bf16(bflo(a.z) * w0 + bflo(bq.z) * w1 + bflo(c.z) * w2, bfhi(a.z) * w0 + bfhi(bq.z) * w1 + bfhi(c.z) * w2);
            o.w = cvt_pk_bf16(bflo(a.w) * w0 + bflo(bq.w) * w1 + bflo(c.w) * w2, bfhi(a.w) * w0 + bfhi(bq.w) * w1 + bfhi(c.w) * w2);
            dst[k] = o; }
    }
}

#ifndef NS_LOOP
#define NS_LOOP 8
#endif
#ifndef REP_P0
#define REP_P0 1
#endif
#ifndef REP_THIN
#define REP_THIN 1
#endif
#ifndef REP_POST
#define REP_POST REP_THIN
#endif
#ifndef REP_ATTN
#define REP_ATTN REP_THIN
#endif
#ifndef REP_COMB
#define REP_COMB REP_THIN
#endif
#ifndef REP_POOL
#define REP_POOL REP_THIN
#endif
#ifndef REP_MIX
#define REP_MIX REP_THIN
#endif
#ifndef REP_FFNIN
#define REP_FFNIN 1
#endif
#ifndef REP_QKV
#define REP_QKV 1
#endif
#ifndef REP_CIN
#define REP_CIN 1
#endif
#ifndef REP_FFNOUT
#define REP_FFNOUT 1
#endif
constexpr int N_PHASES = 28;
constexpr int NMP = MPAD / 256;
__global__ void __launch_bounds__(512, 2) mk_fwd(Args args) {
    extern __shared__ __attribute__((aligned(16))) unsigned char lds_raw[];
    Frame F;
    F.lds = (LAS unsigned char*)lds_raw;
    F.tid = threadIdx.x; F.lane = F.tid & 63; F.wave = __builtin_amdgcn_readfirstlane(F.tid >> 6);
    F.G = gridDim.x; { const int bx = blockIdx.x; F.vcu = (F.G % 8 == 0) ? (bx % 8) * (F.G / 8) + bx / 8 : bx; }
    F.gw = F.vcu * 8 + F.wave; F.NGW = F.G * 8;
    F.in = args.in; F.out = args.out; F.ws = args.ws;
    unsigned char* ws = args.ws;
    volatile LAS unsigned* MISC = (volatile LAS unsigned*)(F.lds + MISC_OFF);
    LAS float* tab = (LAS float*)(F.lds + TAB_OFF);
    LAS float* red = (LAS float*)(F.lds + RED_OFF);
    LAS float* stab = (LAS float*)(F.lds + STAB_OFF);
    const float* spart = (const float*)(ws + WS_SPART);
    for (int u = F.tid; u < (LDS_BYTES - TAB_OFF) / 4; u += 512) ((LAS unsigned*)(F.lds + TAB_OFF))[u] = 0u;
    __syncthreads();
    XcdBarrier bar; bar.bar = (unsigned*)(ws + WS_CTL) + CW_BAR; bar.x = 0; bar.st = nullptr;
    if (args.use_bar) bar = xcd_barrier_post((unsigned*)(ws + WS_CTL) + CW_BAR, MISC + 8);
    const int lo = args.ph_lo, hi = args.ph_hi;
    int ph = 0;
#define OPAQUE_BID() ({ int _c = (int)blockIdx.x; asm volatile("" : "+s"(_c)); _c; })
#define IN_PH() (lo <= ph && ph < hi)
#define SEAM() do { if (IN_PH() && ph + 1 < hi) { if (args.use_bar) xcd_barrier(bar); } ++ph; } while (0)

#ifndef SKIP_P0
    if (IN_PH()) for (int rep = 0; rep < REP_P0; ++rep) p0_prologue(F);
#endif
    SEAM();

#pragma unroll 1
    for (int s = 0; s < NS_LOOP; ++s) {
        const int layer = s >> 1;
        if (IN_PH()) {
#ifndef SKIP_G1
            pg8::Gemm g{(const bf16_t*)(ws + WS_XB), (const bf16_t*)(ws + WS_WIN + (size_t)s * WIN_BYTES)};
            sample_stats(spart, stab, F.tid);
            pg8::StaticOrder S; S.init(NMP, 43, F.G, OPAQUE_BID(), REP_FFNIN);
            pg8::EpiSwiglu E{(bf16_t*)(ws + WS_H), (const float*)(ws + WS_PART), tab, stab};
            pg8::gemm_phase<pg8::EpiSwiglu, D, D, D, 0, PG8_ALIGN, PG8_SP2>(F.lds, g, S, E);
            if (S.c >= 139 && s < 7) {
                int ln = F.lane; asm volatile("" : "+v"(ln)); conv_block_range(F, s + 1, 0, DA, (S.c - 139) * 8 + F.wave, 117 * 8, ln);
#if MIXW_IN_SLACK
                if (s < 5) { const int lo = s == 0 ? 0 : M_E4 + (s - 1) * (I_QKV / 3), hi = s == 0 ? M_E4 : (s == 4 ? I_MIXW : M_E4 + s * (I_QKV / 3));
                    conv_run<1>(F, 0, lo, hi, (S.c - 139) * 8 + F.wave, 117 * 8, ln); }
#endif
                }
#endif
        }
        SEAM();
        if (IN_PH()) {
#ifndef SKIP_G2
            pg8::Gemm g{(const bf16_t*)(ws + WS_H), (const bf16_t*)(ws + WS_WOUT + (size_t)s * WOUT_BYTES)};
            pg8::StaticOrder S; S.init(MPR / 256, 8, F.G, OPAQUE_BID(), REP_FFNOUT);
            const float* gnext = (s & 1) ? (s < 7 ? F.in[6] + (size_t)(layer + 1) * D : nullptr) : F.in[9] + (size_t)layer * D;
            pg8::EpiResT<REP_FFNOUT == 1> E{(float*)(ws + WS_X), (bf16_t*)(ws + WS_XB), (float*)(ws + WS_PART), s == 7 ? F.out : nullptr, nullptr, gnext, red, 0.5f, REP_FFNOUT == 2 ? 1 : 0};
            if (s == 0) E.Xin = F.in[0];
            pg8::gemm_phase<pg8::EpiResT<REP_FFNOUT == 1>, FF, FF, FF, 0, true, PG8_SP2>(F.lds, g, S, E);
            { int ln = F.lane; asm volatile("" : "+v"(ln));
              skinny_out<FF, FF, FF, 0>(F.lds, F.vcu, F.wave, ln, g.A, g.Bt, E.X, E.XB, E.OUT, nullptr, gnext, 0.5f, (float*)(ws + WS_SPART));
              if (F.vcu >= 128 && s < 7) { const int b = s + 1, lo0 = b == 3 ? D3 : b == 4 ? D4 : b == 5 ? D5 : b == 6 ? D6 : DA;
                  conv_block_range(F, b, lo0, imin(lo0 + TAILC, I_FFN), (F.vcu - 128) * 8 + F.wave, 128 * 8, ln); } }
#endif
        }
        SEAM();
        if (s & 1) continue;
        const int kind = layer % 3;
        if (kind == 0) {
            const int j = layer / 3;
#ifndef SKIP_POOL
            if (IN_PH()) for (int rep = 0; rep < REP_POOL; ++rep) pool_phase(F, j, F.in[9] + (size_t)layer * D);
#endif
            SEAM();
            if (IN_PH()) {
#ifndef SKIP_G5
                pg8::Gemm g{(const bf16_t*)(ws + WS_POOLED), (const bf16_t*)(ws + WS_WPOOL + (size_t)j * WPOOL_BYTES)};
                pg8::StaticOrder S; S.init(MPR / 256, 8, F.G, OPAQUE_BID());
                pg8::EpiResT<true> E{(float*)(ws + WS_X), (bf16_t*)(ws + WS_XB), (float*)(ws + WS_PART), nullptr, nullptr, F.in[10] + (size_t)layer * D, red, 1.0f};
                pg8::gemm_phase<pg8::EpiResT<true>, D, 512, 512, 512, true, PG8_SP2>(F.lds, g, S, E);
                { int ln = F.lane; asm volatile("" : "+v"(ln));
                  skinny_out<D, 512, 512, 512>(F.lds, F.vcu, F.wave, ln, g.A, g.Bt, E.X, E.XB, nullptr, nullptr, E.gnext, 1.0f, (float*)(ws + WS_SPART));
                  if (F.vcu >= 128 && s == 0) { _Pragma("unroll 1") for (int b = 1; b < 3; ++b)
                      conv_block_range(F, b, imin(DA + TAILC, I_FFN), I_FFN, (F.vcu - 128) * 8 + F.wave, 128 * 8, ln); } }
#endif
            }
            SEAM();
            continue;
        }
        if (kind == 1) {
            if (IN_PH()) {
#ifndef SKIP_G3
                pg8::Gemm g{(const bf16_t*)(ws + WS_XB), (const bf16_t*)(ws + WS_WCIN)};
                sample_stats(spart, stab, F.tid);
                pg8::StaticOrder S; S.init(MPR / 256, 16, F.G, OPAQUE_BID(), REP_CIN);
                pg8::EpiGelu E{(bf16_t*)(ws + WS_U), (bf16_t*)(ws + WS_V), (float*)(ws + WS_VPART), (const float*)(ws + WS_PART), tab, stab};
                pg8::gemm_phase<pg8::EpiGelu, D, D, D, 0, PG8_ALIGN, PG8_SP2>(F.lds, g, S, E);
                { int ln = F.lane; asm volatile("" : "+v"(ln)); skinny_cin(F.lds, F.vcu, F.wave, ln, g.A, g.Bt, E.U, E.V, (float*)(ws + WS_SVPART), stab); }
#endif
            }
            SEAM();
#ifndef SKIP_MIX
            if (IN_PH()) for (int rep = 0; rep < REP_MIX; ++rep) chunk_mix_phase(F);
#endif
            SEAM();
        } else {
            if (IN_PH()) {
#ifndef SKIP_G4
                pg8::Gemm g{(const bf16_t*)(ws + WS_XB), (const bf16_t*)(ws + WS_WQKV)};
                sample_stats(spart, stab, F.tid);
                pg8::StaticOrder S; S.init(NMP, 72, F.G, OPAQUE_BID(), REP_QKV);
                pg8::EpiQKV E{(bf16_t*)(ws + WS_QP), (bf16_t*)(ws + WS_KP), (bf16_t*)(ws + WS_VB), F.out, (const float*)(ws + WS_CS), F.in[21], F.in[22], (const float*)(ws + WS_PART), tab, stab, red};
                pg8::gemm_phase<pg8::EpiQKV, D, D, D, 0, true, PG8_SP2>(F.lds, g, S, E);
                if (S.c >= 72) { int ln = F.lane; asm volatile("" : "+v"(ln)); _Pragma("unroll 1") for (int b = 5; b < 8; ++b) conv_block_range(F, b, b == 7 ? imin(DA + TAILC, I_FFN) : DA, b == 5 ? D5 : b == 6 ? D6 : I_FFN, (S.c - 72) * 8 + F.wave, 184 * 8, ln); }
#endif
            }
            SEAM();
#ifndef SKIP_ATTN
            if (IN_PH()) for (int rep = 0; rep < REP_ATTN; ++rep) attn_phase(F);
#endif
            SEAM();
#ifndef SKIP_COMB
            if (IN_PH()) for (int rep = 0; rep < REP_COMB; ++rep) attn_combine_phase(F);
#endif
            SEAM();
        }
        if (IN_PH()) {
#ifndef SKIP_G6
            pg8::Gemm g{(const bf16_t*)(ws + (kind == 1 ? WS_Y : WS_OC)), (const bf16_t*)(ws + (kind == 1 ? WS_WCOUT : WS_WAO))};
            pg8::StaticOrder S; S.init(MPR / 256, 8, F.G, OPAQUE_BID());
            pg8::EpiResT<true> E{(float*)(ws + WS_X), (bf16_t*)(ws + WS_XB), (float*)(ws + WS_PART), nullptr, nullptr, F.in[10] + (size_t)layer * D, red, 1.0f};
            pg8::gemm_phase<pg8::EpiResT<true>, D, D, D, 0, true, PG8_SP2>(F.lds, g, S, E);
            { int ln = F.lane; asm volatile("" : "+v"(ln));
              skinny_out<D, D, D, 0>(F.lds, F.vcu, F.wave, ln, g.A, g.Bt, E.X, E.XB, nullptr, nullptr, E.gnext, 1.0f, (float*)(ws + WS_SPART));
              if (F.vcu >= 128 && s == 2) { _Pragma("unroll 1") for (int b = 3; b < 5; ++b) { const int lo0 = b == 3 ? D3 : D4;
                  conv_block_range(F, b, imin(lo0 + TAILC, I_FFN), I_FFN, (F.vcu - 128) * 8 + F.wave, 128 * 8, ln); } } }
#endif
        }
        SEAM();
    }
#undef IN_PH
#undef SEAM
}

extern "C" void kernel_launch(void* const* d_in, const int* in_sizes, int n_in, void* d_out, int out_size, void* d_ws, size_t ws_size, hipStream_t stream) {
    static int grid = 0;
    if (grid == 0) {
        if (n_in != 24 || (size_t)out_size != O_END || ws_size < WS_END) { fprintf(stderr, "kernel_launch: unexpected shapes: n_in %d out %d ws %zu (need %zu)\n", n_in, out_size, ws_size, (size_t)WS_END); grid = -1; return; }
        int dev = 0, cus = 0, per_cu = 0;
        if (hipGetDevice(&dev) != hipSuccess || hipDeviceGetAttribute(&cus, hipDeviceAttributeMultiprocessorCount, dev) != hipSuccess) { grid = -1; return; }
        if (hipFuncSetAttribute((const void*)mk_fwd, hipFuncAttributeMaxDynamicSharedMemorySize, LDS_BYTES) != hipSuccess) { fprintf(stderr, "kernel_launch: hipFuncSetAttribute failed\n"); grid = -1; return; }
        if (hipOccupancyMaxActiveBlocksPerMultiprocessor(&per_cu, (const void*)mk_fwd, 512, LDS_BYTES) != hipSuccess || per_cu < 1) fprintf(stderr, "kernel_launch: occupancy query says %d\n", per_cu);
        (void)hipGetLastError();
        grid = cus;
    }
    if (grid < 0) return;
    (void)hipMemsetAsync((char*)d_ws + WS_CTL, 0, CTL_ZERO_BYTES, stream);
    Args a{};
    for (int i = 0; i < 24; ++i) a.in[i] = (const float*)d_in[i];
    a.out = (float*)d_out; a.ws = (unsigned char*)d_ws;
#if MK_N_LAUNCHES == 1
    a.ph_lo = 0; a.ph_hi = N_PHASES; a.use_bar = 1; a.pad = 0;
    hipLaunchKernelGGL(mk_fwd, dim3(grid), dim3(512), LDS_BYTES, stream, a);
#else
    for (int p = 0; p < N_PHASES; ++p) { a.ph_lo = p; a.ph_hi = p + 1; a.use_bar = 0; a.pad = 0; hipLaunchKernelGGL(mk_fwd, dim3(grid), dim3(512), LDS_BYTES, stream, a); }
#endif
}
```
